# Optimizing an MI355X kernel written in HIP

```python
import math
import jax, jax.numpy as jnp
from jax import lax
import numpy as np

D_MODEL = 1024
BATCH = 4
SEQ = 4096
DEPTH = 4
DEC_BATCH = 32
DEC_SEQ = 4
PAST_LEN = 8192
PAGE_SIZE = 128

HEAD_DIM = 64
MIX_WIDTH = D_MODEL
CONV_WIDTH = MIX_WIDTH // 4
RWKV_WIDTH = MIX_WIDTH // 4
ATT_WIDTH = MIX_WIDTH - CONV_WIDTH - RWKV_WIDTH
N_RWKV_HEADS = RWKV_WIDTH // HEAD_DIM
N_ATT_HEADS = ATT_WIDTH // HEAD_DIM
CONV_K = 31
DECAY_LORA = 64
AAA_LORA = 64
GATE_LORA = 128
CONV_COLS = 2 * CONV_WIDTH
RWKV_COLS = 3 * RWKV_WIDTH + DECAY_LORA + AAA_LORA + GATE_LORA
ATT_COLS = 3 * ATT_WIDTH
IN_COLS = CONV_COLS + RWKV_COLS + ATT_COLS
DILATIONS = ((128, 1), (512, 4), (2048, 16))
MAX_WINDOW = max(w for w, _ in DILATIONS)
BLOCK = 128
N_REL_BUCKETS = 32
REL_EXACT = N_REL_BUCKETS // 2
REL_MAX_DIST = MAX_WINDOW
D_FF = -(-8 * D_MODEL // (3 * 256)) * 256
RMS_EPS = 1e-6
LN_EPS = 1e-5
RWKV_GN_EPS = HEAD_DIM * 1e-5
DECAY_SCALE = math.exp(-0.5)
NEG_INF = -1e30

kernel_name = 'hymba_conv_rwkv7_dilated_attn_step'


def rms_norm(x, g):
    xf = x.astype(jnp.float32)
    y = xf * lax.rsqrt(jnp.mean(xf * xf, -1, keepdims=True) + RMS_EPS)
    return (y * g).astype(x.dtype)


def layer_norm(x, g, b):
    xf = x.astype(jnp.float32)
    mu = jnp.mean(xf, -1, keepdims=True)
    var = jnp.mean(jnp.square(xf - mu), -1, keepdims=True)
    return ((xf - mu) * lax.rsqrt(var + LN_EPS) * g + b).astype(x.dtype)


def rel_bucket(dist):
    d = jnp.maximum(dist, 1).astype(jnp.float32)
    large = REL_EXACT + (jnp.log(d / REL_EXACT) / math.log(REL_MAX_DIST / REL_EXACT)
                         * (N_REL_BUCKETS - REL_EXACT)).astype(jnp.int32)
    large = jnp.minimum(large, N_REL_BUCKETS - 1)
    return jnp.where(dist < REL_EXACT, dist, large)


def depthwise_causal_conv(zc, w, b):
    y = lax.conv_general_dilated(zc, w[:, None, :].astype(zc.dtype), window_strides=(1,), padding='VALID',
                                 dimension_numbers=('NWC', 'WIO', 'NWC'), feature_group_count=zc.shape[-1])
    return y + b


def wkv_scan(s0, r, w, k, v, kk, a):
    def step(s, inp):
        r_t, w_t, k_t, v_t, kk_t, a_t = inp
        s_kk = jnp.einsum('nhvk,nhk->nhv', s, kk_t)
        s = (s * w_t[:, :, None, :] - s_kk[..., None] * (kk_t * a_t)[:, :, None, :]
             + v_t[..., None] * k_t[:, :, None, :])
        return s, jnp.einsum('nhvk,nhk->nhv', s, r_t)
    seqs = tuple(jnp.moveaxis(z, 1, 0) for z in (r, w, k, v, kk, a))
    s, y = lax.scan(step, s0, seqs)
    return jnp.moveaxis(y, 0, 1), s


def rwkv_mixer(u, prev, s0, p):
    n, t = u.shape[:2]
    uf = u.astype(jnp.float32)
    u_prev = jnp.concatenate([prev.astype(jnp.float32)[:, None], uf[:, :-1]], axis=1)
    xs = uf + (u_prev - uf) * p['rwkv_mu']
    o = 3 * RWKV_WIDTH
    r = xs[..., :RWKV_WIDTH]
    k = xs[..., RWKV_WIDTH:2 * RWKV_WIDTH]
    v = xs[..., 2 * RWKV_WIDTH:o]
    w_lo = xs[..., o:o + DECAY_LORA]
    a_lo = xs[..., o + DECAY_LORA:o + DECAY_LORA + AAA_LORA]
    g_lo = xs[..., o + DECAY_LORA + AAA_LORA:]
    w_log = -DECAY_SCALE * jax.nn.sigmoid(p['rwkv_w0'] + jnp.tanh(w_lo) @ p['rwkv_w2'])
    a = jax.nn.sigmoid(p['rwkv_a0'] + a_lo @ p['rwkv_a2'])
    g = jax.nn.sigmoid(g_lo) @ p['rwkv_g2']
    heads = lambda z: z.reshape(n, t, N_RWKV_HEADS, HEAD_DIM).astype(jnp.float32)
    kk = heads(k * p['rwkv_k_k'])
    kk = kk / jnp.maximum(jnp.sqrt(jnp.sum(kk * kk, -1, keepdims=True)), 1e-12)
    k = k * (1.0 + (a - 1.0) * p['rwkv_k_a'])
    rh, kh, vh, ah = heads(r), heads(k), heads(v), heads(a)
    y, s = wkv_scan(s0, rh, heads(jnp.exp(w_log)), kh, vh, kk, ah)
    mu = jnp.mean(y, -1, keepdims=True)
    var = jnp.mean(jnp.square(y - mu), -1, keepdims=True)
    y = ((y - mu) * lax.rsqrt(var + RWKV_GN_EPS)).reshape(n, t, RWKV_WIDTH) * p['rwkv_ln_g'] + p['rwkv_ln_b']
    bonus = jnp.sum(rh * kh * p['rwkv_r_k'], -1, keepdims=True) * vh
    y = (y + bonus.reshape(n, t, RWKV_WIDTH)) * g
    return y.astype(u.dtype), u[:, -1], s


def merge_by_denominator(outs, maxes, sums):
    m = jnp.stack(maxes)
    l = jnp.stack(sums)
    o = jnp.stack(outs)
    wts = l * jnp.exp(m - jnp.max(m, 0, keepdims=True))
    return jnp.sum(wts[..., None] * o, 0) / jnp.sum(wts, 0)[..., None]


def dilated_attn_prompt(q, k, v, rel_bias):
    n, t = q.shape[:2]
    qf, kf, vf = (z.astype(jnp.float32) for z in (q, k, v))
    scale = HEAD_DIM ** -0.5
    qi = jnp.arange(BLOCK)[:, None]
    kj = jnp.arange(2 * BLOCK)[None, :]
    delta = qi + BLOCK - kj
    outs, maxes, sums = [], [], []
    for window, dil in DILATIONS:
        span = window // dil
        unit = dil * BLOCK
        tp = -(-t // unit) * unit
        nb = tp // unit

        def to_blocks(z):
            z = jnp.pad(z, ((0, 0), (0, tp - t), (0, 0), (0, 0)))
            return z.reshape(n, nb, BLOCK, dil, N_ATT_HEADS, HEAD_DIM)

        def with_prev(z):
            prev = jnp.concatenate([jnp.zeros_like(z[:, :1]), z[:, :-1]], axis=1)
            return jnp.concatenate([prev, z], axis=2)

        qb = to_blocks(qf)
        kw = with_prev(to_blocks(kf))
        vw = with_prev(to_blocks(vf))
        band = (delta >= 0) & (delta <= span)
        first = (jnp.arange(nb)[:, None] > 0) | (jnp.arange(2 * BLOCK)[None, :] >= BLOCK)
        mask = band[None] & first[:, None, :]
        bias = rel_bias[rel_bucket(jnp.maximum(delta, 0) * dil)].astype(jnp.float32)
        s = (jnp.einsum('nbqrhd,nbkrhd->nbrhqk', qb, kw) * scale
             + jnp.transpose(bias, (2, 0, 1))[None, None, None])
        s = jnp.where(mask[None, :, None, None], s, NEG_INF)
        m = jnp.max(s, -1)
        pr = jnp.exp(s - m[..., None])
        l = jnp.sum(pr, -1)
        o = jnp.einsum('nbrhqk,nbkrhd->nbqrhd', pr, vw) / jnp.transpose(l, (0, 1, 4, 2, 3))[..., None]
        outs.append(o.reshape(n, tp, N_ATT_HEADS, HEAD_DIM)[:, :t])
        maxes.append(jnp.transpose(m, (0, 1, 4, 2, 3)).reshape(n, tp, N_ATT_HEADS)[:, :t])
        sums.append(jnp.transpose(l, (0, 1, 4, 2, 3)).reshape(n, tp, N_ATT_HEADS)[:, :t])
    return merge_by_denominator(outs, maxes, sums)


def dilated_attn_sample(q, k, v, k_buf, v_buf, rel_bias):
    n, s = q.shape[:2]
    w = k_buf.shape[1]
    kc = jnp.concatenate([k_buf.astype(jnp.float32), k.astype(jnp.float32)], axis=1)
    vc = jnp.concatenate([v_buf.astype(jnp.float32), v.astype(jnp.float32)], axis=1)
    qf = q.astype(jnp.float32)
    scale = HEAD_DIM ** -0.5
    pos = jnp.arange(s)[:, None]
    outs, maxes, sums = [], [], []
    for window, dil in DILATIONS:
        steps = jnp.arange(window // dil + 1)
        idx = w + pos - steps[None, :] * dil
        valid = idx >= 0
        idx = jnp.maximum(idx, 0)
        kg = kc[:, idx]
        vg = vc[:, idx]
        bias = rel_bias[rel_bucket(steps * dil)].astype(jnp.float32).T
        sc = jnp.einsum('nshd,nsmhd->nshm', qf, kg) * scale + bias[None, None]
        sc = jnp.where(valid[None, :, None, :], sc, NEG_INF)
        m = jnp.max(sc, -1)
        pr = jnp.exp(sc - m[..., None])
        l = jnp.sum(pr, -1)
        outs.append(jnp.einsum('nshm,nsmhd->nshd', pr, vg) / l[..., None])
        maxes.append(m)
        sums.append(l)
    return merge_by_denominator(outs, maxes, sums)


def block(x, c, p, rel_bias, state):
    n, t = x.shape[:2]
    mod = (jax.nn.silu(c) @ p['w_ada'] + p['b_ada']).reshape(n, 6, 1, D_MODEL)
    shift1, scale1, gate1, shift2, scale2, gate2 = (mod[:, j] for j in range(6))
    h = rms_norm(x, p['g_pre_mix']) * (1 + scale1) + shift1
    u = h @ p['w_in']
    u_conv = u[..., :CONV_COLS]
    u_rwkv = u[..., CONV_COLS:CONV_COLS + RWKV_COLS]
    u_att = u[..., CONV_COLS + RWKV_COLS:]
    if state is None:
        conv_buf = jnp.zeros((n, CONV_K - 1, CONV_WIDTH), u.dtype)
        shift_prev = jnp.zeros((n, RWKV_COLS), u.dtype)
        wkv0 = jnp.zeros((n, N_RWKV_HEADS, HEAD_DIM, HEAD_DIM), jnp.float32)
    else:
        conv_buf, shift_prev, wkv0, k_buf, v_buf = state
    z = u_conv[..., :CONV_WIDTH] * jax.nn.sigmoid(u_conv[..., CONV_WIDTH:])
    zc = jnp.concatenate([conv_buf.astype(z.dtype), z], axis=1)
    y_a = jax.nn.silu(layer_norm(depthwise_causal_conv(zc, p['conv_w'], p['conv_b']),
                                 p['conv_ln_g'], p['conv_ln_b'])).astype(x.dtype)
    y_b, new_shift, new_wkv = rwkv_mixer(u_rwkv, shift_prev, wkv0.astype(jnp.float32), p)
    q, k, v = (u_att[..., i * ATT_WIDTH:(i + 1) * ATT_WIDTH].reshape(n, t, N_ATT_HEADS, HEAD_DIM)
               for i in range(3))
    if state is None:
        y_c = dilated_attn_prompt(q, k, v, rel_bias)
        win = min(MAX_WINDOW, t)
        new_k, new_v = k[:, t - win:], v[:, t - win:]
    else:
        y_c = dilated_attn_sample(q, k, v, k_buf, v_buf, rel_bias)
        new_k, new_v = k, v
    mix = jnp.concatenate([y_a, y_b.astype(x.dtype), y_c.reshape(n, t, ATT_WIDTH).astype(x.dtype)], -1) @ p['w_out']
    x = x + gate1 * rms_norm(mix, p['g_post_mix'])
    h = rms_norm(x, p['g_pre_ffn']) * (1 + scale2) + shift2
    gu = h @ p['w_ffn_in']
    f = (jax.nn.silu(gu[..., :D_FF]) * gu[..., D_FF:]) @ p['w_ffn_out']
    x = x + gate2 * rms_norm(f, p['g_post_ffn'])
    return x, (zc[:, -(CONV_K - 1):], new_shift, new_wkv.astype(x.dtype), new_k, new_v)


def setup_inputs(seed: int = 0) -> dict:
    key = jax.random.key(seed)
    ks = iter(jax.random.split(key, 40))
    nrm = lambda shape, s: jax.random.normal(next(ks), shape, jnp.float32) * s
    gain = lambda shape: 1.0 + nrm(shape, 0.02)
    win_buf = min(MAX_WINDOW, PAST_LEN)
    return {
        'x_prompt': nrm((BATCH, SEQ, D_MODEL), 1.0),
        'x_sample': nrm((DEC_BATCH, DEC_SEQ, D_MODEL), 1.0),
        'c_prompt': nrm((BATCH, D_MODEL), 1.0),
        'c_sample': nrm((DEC_BATCH, D_MODEL), 1.0),
        'cache_conv': nrm((DEPTH, DEC_BATCH, CONV_K - 1, CONV_WIDTH), 0.5),
        'state_shift': nrm((DEPTH, DEC_BATCH, RWKV_COLS), 1.0),
        'state_wkv': nrm((DEPTH, DEC_BATCH, N_RWKV_HEADS, HEAD_DIM, HEAD_DIM), 0.3),
        'cache_k_win': nrm((DEPTH, DEC_BATCH, win_buf, N_ATT_HEADS, HEAD_DIM), 1.0),
        'cache_v_win': nrm((DEPTH, DEC_BATCH, win_buf, N_ATT_HEADS, HEAD_DIM), 1.0),
        'w_ada': nrm((DEPTH, D_MODEL, 6 * D_MODEL), 0.5 * D_MODEL ** -0.5),
        'b_ada': nrm((DEPTH, 6 * D_MODEL), 0.02),
        'g_pre_mix': gain((DEPTH, D_MODEL)),
        'g_post_mix': gain((DEPTH, D_MODEL)),
        'g_pre_ffn': gain((DEPTH, D_MODEL)),
        'g_post_ffn': gain((DEPTH, D_MODEL)),
        'w_in': nrm((DEPTH, D_MODEL, IN_COLS), D_MODEL ** -0.5),
        'w_out': nrm((DEPTH, MIX_WIDTH, D_MODEL), MIX_WIDTH ** -0.5),
        'conv_w': nrm((DEPTH, CONV_K, CONV_WIDTH), CONV_K ** -0.5),
        'conv_b': nrm((DEPTH, CONV_WIDTH), 0.01),
        'conv_ln_g': gain((DEPTH, CONV_WIDTH)),
        'conv_ln_b': nrm((DEPTH, CONV_WIDTH), 0.01),
        'rwkv_mu': jax.random.uniform(next(ks), (DEPTH, RWKV_COLS), jnp.float32),
        'rwkv_w0': nrm((DEPTH, RWKV_WIDTH), 0.5),
        'rwkv_w2': nrm((DEPTH, DECAY_LORA, RWKV_WIDTH), 0.5 * DECAY_LORA ** -0.5),
        'rwkv_a0': nrm((DEPTH, RWKV_WIDTH), 0.5),
        'rwkv_a2': nrm((DEPTH, AAA_LORA, RWKV_WIDTH), 0.5 * AAA_LORA ** -0.5),
        'rwkv_g2': nrm((DEPTH, GATE_LORA, RWKV_WIDTH), GATE_LORA ** -0.5),
        'rwkv_k_k': 1.0 + nrm((DEPTH, RWKV_WIDTH), 0.1),
        'rwkv_k_a': 1.0 + nrm((DEPTH, RWKV_WIDTH), 0.1),
        'rwkv_r_k': nrm((DEPTH, N_RWKV_HEADS, HEAD_DIM), 0.1),
        'rwkv_ln_g': gain((DEPTH, RWKV_WIDTH)),
        'rwkv_ln_b': nrm((DEPTH, RWKV_WIDTH), 0.01),
        'rel_bias': nrm((N_REL_BUCKETS, N_ATT_HEADS), 0.2),
        'w_ffn_in': nrm((DEPTH, D_MODEL, 2 * D_FF), D_MODEL ** -0.5),
        'w_ffn_out': nrm((DEPTH, D_FF, D_MODEL), D_FF ** -0.5),
    }


def reference(x_prompt, x_sample, c_prompt, c_sample, cache_conv, state_shift, state_wkv, cache_k_win, cache_v_win,
              w_ada, b_ada, g_pre_mix, g_post_mix, g_pre_ffn, g_post_ffn, w_in, w_out,
              conv_w, conv_b, conv_ln_g, conv_ln_b,
              rwkv_mu, rwkv_w0, rwkv_w2, rwkv_a0, rwkv_a2, rwkv_g2, rwkv_k_k, rwkv_k_a, rwkv_r_k,
              rwkv_ln_g, rwkv_ln_b, rel_bias, w_ffn_in, w_ffn_out):
    yp, ys = x_prompt, x_sample
    conv_p, conv_s, shift_p, shift_s, wkv_p, wkv_s = [], [], [], [], [], []
    kp, ks_, vp, vs = [], [], [], []
    for li in range(DEPTH):
        p = dict(w_ada=w_ada[li], b_ada=b_ada[li], g_pre_mix=g_pre_mix[li], g_post_mix=g_post_mix[li],
                 g_pre_ffn=g_pre_ffn[li], g_post_ffn=g_post_ffn[li], w_in=w_in[li], w_out=w_out[li],
                 conv_w=conv_w[li], conv_b=conv_b[li], conv_ln_g=conv_ln_g[li], conv_ln_b=conv_ln_b[li],
                 rwkv_mu=rwkv_mu[li], rwkv_w0=rwkv_w0[li], rwkv_w2=rwkv_w2[li], rwkv_a0=rwkv_a0[li],
                 rwkv_a2=rwkv_a2[li], rwkv_g2=rwkv_g2[li], rwkv_k_k=rwkv_k_k[li], rwkv_k_a=rwkv_k_a[li],
                 rwkv_r_k=rwkv_r_k[li], rwkv_ln_g=rwkv_ln_g[li], rwkv_ln_b=rwkv_ln_b[li],
                 w_ffn_in=w_ffn_in[li], w_ffn_out=w_ffn_out[li])
        yp, (cb, sh, wk, kn, vn) = block(yp, c_prompt, p, rel_bias, None)
        conv_p.append(cb); shift_p.append(sh); wkv_p.append(wk); kp.append(kn); vp.append(vn)
        ys, (cb, sh, wk, kn, vn) = block(ys, c_sample, p, rel_bias,
                                         (cache_conv[li], state_shift[li], state_wkv[li],
                                          cache_k_win[li], cache_v_win[li]))
        conv_s.append(cb); shift_s.append(sh); wkv_s.append(wk); ks_.append(kn); vs.append(vn)
    return (yp, ys,
            jnp.stack(conv_p), jnp.stack(conv_s),
            jnp.stack(shift_p), jnp.stack(shift_s),
            jnp.stack(wkv_p), jnp.stack(wkv_s),
            jnp.stack(kp), jnp.stack(ks_),
            jnp.stack(vp), jnp.stack(vs))
```

```cpp
#include <hip/hip_runtime.h>
#include <cstdio>
#include <cstdint>
namespace pg8 {
#define PG8_LAS __attribute__((address_space(3)))
typedef unsigned short bf16_t;
typedef short bf16x8 __attribute__((ext_vector_type(8)));
typedef float f32x4 __attribute__((ext_vector_type(4)));
typedef unsigned u32x4 __attribute__((ext_vector_type(4)));
constexpr int BM = 256, BK = 64, HALF = 128, HTB = HALF * BK * 2  , STAGE_BYTES = 8 * HTB, NXCD = 8, WGM = 8;

__host__ __device__ __forceinline__ int lds_byte(int r, int c) { const int st = (r >> 4) * 2 + (c >> 5), rr = r & 15, cc = c & 31, ob = rr * 64 + cc * 2; return st * 1024 + (ob ^ (((ob >> 9) & 1) << 5)); }
__host__ __device__ __forceinline__ void stage_rc(int b, int& R, int& C) { const int st = b / 1024, sb = b % 1024, swz = sb ^ (((sb >> 9) & 1) << 5); R = (st >> 1) * 16 + swz / 64; C = (st & 1) * 32 + (swz % 64) / 2; }
__host__ __device__ __forceinline__ int perm32(int rho) { const int n = rho >> 4, i = rho & 15; return 8 * (i >> 2) + 4 * n + (i & 3); }

struct Unit { int pm, pn; };
struct Gemm { const bf16_t* A; const bf16_t* Bt; int M, N, K; };

struct StaticOrder {
    int nM, nN, nwg, G, c;
    __host__ __device__ void init(int M, int N, int G_, int c_) { nM = M / BM; nN = N / BM; nwg = nM * nN; G = G_; c = c_; }
    __host__ __device__ bool next(int i, Unit& u) const {
        const long L = (long)i * G + c; if (L >= nwg) return false;
        int wgid = (int)L; { const int q = nwg / NXCD, r = nwg % NXCD, xcd = wgid % NXCD, off = wgid / NXCD; wgid = (xcd < r ? xcd * (q + 1) : r * (q + 1) + (xcd - r) * q) + off; }
        const int nig = WGM * nN, gid = wgid / nig, fm = gid * WGM, gsz = (nM - fm) < WGM ? (nM - fm) : WGM;
        u.pm = fm + ((wgid % nig) % gsz); u.pn = (wgid % nig) / gsz; return true;
    }
    __device__ __forceinline__ void a_ready(const Unit&) const {}
    __device__ __forceinline__ void done(const Unit&) const {}
};

__device__ __forceinline__ unsigned cvt_pk_bf16(float lo, float hi) { unsigned r; asm volatile("v_cvt_pk_bf16_f32 %0, %1, %2" : "=v"(r) : "v"(lo), "v"(hi)); return r; }
typedef float f32x2 __attribute__((ext_vector_type(2)));
struct EpiBf16 {
    static constexpr bool PERM = true, AFTER_DRAIN = false;
    bf16_t* O; int ldc;
    __device__ __forceinline__ void operator()(const f32x4 (&acc)[2][2][4][2], const Unit& u, int wr, int wc, int fr, int fq) const {
        const int row0 = u.pm * BM + wr * 64 + fr; const int col0 = u.pn * BM + wc * 32 + 8 * fq;
#pragma unroll
        for (int ai = 0; ai < 2; ++ai)
#pragma unroll
            for (int m = 0; m < 4; ++m) { bf16_t* rowp = O + (size_t)(row0 + ai * HALF + m * 16) * ldc + col0;
#pragma unroll
                for (int bj = 0; bj < 2; ++bj) { const f32x4 v0 = acc[ai][bj][m][0], v1 = acc[ai][bj][m][1];
                    u32x4 w; w.x = cvt_pk_bf16(v0[0], v0[1]); w.y = cvt_pk_bf16(v0[2], v0[3]); w.z = cvt_pk_bf16(v1[0], v1[1]); w.w = cvt_pk_bf16(v1[2], v1[3]);
                    *(u32x4*)(rowp + bj * HALF) = w; } }
    }
};
struct EpiF32 {
    static constexpr bool PERM = false, AFTER_DRAIN = false;
    float* C; int ldc;
    __device__ __forceinline__ void operator()(const f32x4 (&acc)[2][2][4][2], const Unit& u, int wr, int wc, int fr, int fq) const {
        const int row0 = u.pm * BM + wr * 64 + fr, col0 = u.pn * BM + wc * 32 + 4 * fq;
#pragma unroll
        for (int ai = 0; ai < 2; ++ai)
#pragma unroll
            for (int m = 0; m < 4; ++m) { float* rowp = C + (size_t)(row0 + ai * HALF + m * 16) * ldc + col0;
#pragma unroll
                for (int bj = 0; bj < 2; ++bj)
#pragma unroll
                    for (int n = 0; n < 2; ++n) *(f32x4*)(rowp + bj * HALF + n * 16) = acc[ai][bj][m][n]; }
    }
};
__device__ __forceinline__ float silu_f(float x) { return x / (1.0f + __expf(-x)); }
struct EpiSwiGLU {
    static constexpr bool PERM = true, AFTER_DRAIN = false;
    bf16_t* O; int ldc;
    __device__ __forceinline__ void operator()(const f32x4 (&acc)[2][2][4][2], const Unit& u, int wr, int wc, int fr, int fq) const {
        const int row0 = u.pm * BM + wr * 64 + fr; const int col0 = u.pn * HALF + wc * 32 + 8 * fq;
#pragma unroll
        for (int ai = 0; ai < 2; ++ai)
#pragma unroll
            for (int m = 0; m < 4; ++m) { bf16_t* rowp = O + (size_t)(row0 + ai * HALF + m * 16) * ldc + col0;
                const f32x4 g0 = acc[ai][0][m][0], g1 = acc[ai][0][m][1], u0 = acc[ai][1][m][0], u1 = acc[ai][1][m][1];
                f32x4 v0, v1;
#pragma unroll
                for (int j = 0; j < 4; ++j) { v0[j] = silu_f(g0[j]) * u0[j]; v1[j] = silu_f(g1[j]) * u1[j]; }
                u32x4 w; w.x = cvt_pk_bf16(v0[0], v0[1]); w.y = cvt_pk_bf16(v0[2], v0[3]); w.z = cvt_pk_bf16(v1[0], v1[1]); w.w = cvt_pk_bf16(v1[2], v1[3]);
                *(u32x4*)rowp = w; }
    }
};
template <class Epi, class Sched, bool ALIGN_EPI = false, bool SP2 = false>
__device__ __forceinline__ void gemm_phase(PG8_LAS unsigned char* lds, const Gemm g, const Sched& S, const Epi& E) {
    const int tid = threadIdx.x, wid = __builtin_amdgcn_readfirstlane(tid >> 6), lane = tid & 63, wr = wid >> 2, wc = wid & 3, fr = lane & 15, fq = lane >> 4;
    const int K = g.K, nt = K / BK;
    unsigned voffA[2], voffB[2];
#pragma unroll
    for (int i = 0; i < 2; ++i) { int R, C; stage_rc(tid * 16 + i * 8192, R, C); const int Rb = Epi::PERM ? ((R & ~31) + perm32(R & 31)) : R;
        voffA[i] = (unsigned)(R * K + C) * 2u; voffB[i] = (unsigned)(Rb * K + C) * 2u; }
    const size_t kstep = (size_t)(BK * 2);
    const size_t hstep = (size_t)HALF * K * 2;
    const size_t tstep = 2 * hstep;
    const unsigned ldsw = (unsigned)wid * 1024u;
    const int aoff = lds_byte(wr * 64 + fr, fq * 8), boff = lds_byte(wc * 32 + fr, fq * 8);
#define PG8_SA(b, h) (((b) * 2 + (h)) * HTB)
#define PG8_SB(b, h) ((4 + (b) * 2 + (h)) * HTB)
#define PG8_STAGE(bufoff, gbase, voff) do { _Pragma("unroll") for (int _i = 0; _i < 2; ++_i) \
        __builtin_amdgcn_global_load_lds((const unsigned*)((const char*)(gbase) + (voff)[_i]), (PG8_LAS unsigned*)(lds + (bufoff) + ldsw + _i * 8192), 16, 0, 0); } while (0)
#define PG8_LDA(dst, b, h) do { _Pragma("unroll") for (int m = 0; m < 4; ++m) _Pragma("unroll") for (int k = 0; k < 2; ++k) dst[m][k] = *(const PG8_LAS bf16x8*)(lds + PG8_SA(b, h) + aoff + m * 2048 + k * 1024); } while (0)
#define PG8_LDB(dst, b, h) do { _Pragma("unroll") for (int n = 0; n < 2; ++n) _Pragma("unroll") for (int k = 0; k < 2; ++k) dst[n][k] = *(const PG8_LAS bf16x8*)(lds + PG8_SB(b, h) + boff + n * 2048 + k * 1024); } while (0)
#define PG8_MMA(ai, bj, At, Bt) do { __builtin_amdgcn_s_setprio(1); _Pragma("unroll") for (int m = 0; m < 4; ++m) _Pragma("unroll") for (int n = 0; n < 2; ++n) _Pragma("unroll") for (int k = 0; k < 2; ++k) \
        acc[ai][bj][m][n] = __builtin_amdgcn_mfma_f32_16x16x32_bf16(Bt[n][k], At[m][k], acc[ai][bj][m][n], 0, 0, 0); __builtin_amdgcn_s_setprio(0); } while (0)
#define PG8_WAIT_V(n) asm volatile("s_waitcnt vmcnt(" #n ")" ::: "memory")
#define PG8_WAIT_L(n) asm volatile("s_waitcnt lgkmcnt(" #n ")" ::: "memory")
#define PG8_BAR __builtin_amdgcn_s_barrier()
#define PG8_SCHED __builtin_amdgcn_sched_barrier(0)
    Unit cur, nxt; int ui = 0;
    if (!S.next(0, cur)) return;
    f32x4 acc[2][2][4][2];
#pragma unroll
    for (int a = 0; a < 2; ++a)
#pragma unroll
        for (int b = 0; b < 2; ++b)
#pragma unroll
            for (int m = 0; m < 4; ++m)
#pragma unroll
                for (int n = 0; n < 2; ++n) acc[a][b][m][n] = (f32x4){0.f, 0.f, 0.f, 0.f};
    bf16x8 At[4][2], B0[2][2], B1[2][2];
    const char* cA = (const char*)g.A + (size_t)cur.pm * tstep; const char* cB = (const char*)g.Bt + (size_t)cur.pn * tstep;
    S.a_ready(cur);
    if constexpr (SP2) {
        PG8_STAGE(PG8_SB(0, 0), cB, voffB); PG8_STAGE(PG8_SB(0, 1), cB + hstep, voffB); PG8_STAGE(PG8_SA(0, 0), cA, voffA); PG8_STAGE(PG8_SA(0, 1), cA + hstep, voffA);
        if (wr == 1) PG8_BAR;
        PG8_WAIT_V(2); PG8_BAR;
        PG8_STAGE(PG8_SB(1, 0), cB + kstep, voffB); PG8_STAGE(PG8_SA(1, 0), cA + kstep, voffA); PG8_STAGE(PG8_SB(1, 1), cB + hstep + kstep, voffB);
        PG8_WAIT_V(6); PG8_BAR;
    } else {
        PG8_STAGE(PG8_SB(0, 0), cB, voffB); PG8_STAGE(PG8_SA(0, 0), cA, voffA); PG8_STAGE(PG8_SB(0, 1), cB + hstep, voffB); PG8_STAGE(PG8_SA(0, 1), cA + hstep, voffA);
        if (wr == 1) PG8_BAR;
        PG8_WAIT_V(4); PG8_BAR;
        PG8_STAGE(PG8_SB(1, 0), cB + kstep, voffB); PG8_STAGE(PG8_SA(1, 0), cA + kstep, voffA); PG8_STAGE(PG8_SB(1, 1), cB + hstep + kstep, voffB);
        PG8_WAIT_V(6); PG8_BAR;
    }
    for (;;) {
        const bool has_next = S.next(ui + 1, nxt);
        const char* nA = has_next ? (const char*)g.A + (size_t)nxt.pm * tstep : cA; const char* nB = has_next ? (const char*)g.Bt + (size_t)nxt.pn * tstep : cB;
        for (int t = 0; t < nt; t += 2) {
            const bool last = (t == nt - 2);
            const char* a1 = cA + (size_t)(t + 1) * kstep;
            const char* a2 = last ? nA : cA + (size_t)(t + 2) * kstep; const char* b2 = last ? nB : cB + (size_t)(t + 2) * kstep;
            const char* a3 = a2 + kstep; const char* b3 = b2 + kstep;
            if (last && has_next) S.a_ready(nxt);
            if constexpr (SP2) {
            PG8_LDB(B0, 0, 0); PG8_LDB(B1, 0, 1); PG8_SCHED; PG8_LDA(At, 0, 0); PG8_STAGE(PG8_SA(1, 1), a1 + hstep, voffA);
            PG8_WAIT_V(8); PG8_WAIT_L(0); PG8_BAR; PG8_MMA(0, 0, At, B0); PG8_MMA(0, 1, At, B1); PG8_BAR; PG8_SCHED;
            PG8_LDA(At, 0, 1); PG8_STAGE(PG8_SB(0, 0), b2, voffB); PG8_STAGE(PG8_SB(0, 1), b2 + hstep, voffB); PG8_STAGE(PG8_SA(0, 0), a2, voffA);
            PG8_WAIT_V(8); PG8_WAIT_L(0); PG8_BAR; PG8_MMA(1, 0, At, B0); PG8_MMA(1, 1, At, B1); PG8_BAR; PG8_SCHED;
            PG8_LDB(B0, 1, 0); PG8_LDB(B1, 1, 1); PG8_SCHED; PG8_LDA(At, 1, 0); PG8_STAGE(PG8_SA(0, 1), a2 + hstep, voffA);
            PG8_WAIT_V(8); PG8_WAIT_L(0); PG8_BAR; PG8_MMA(0, 0, At, B0); PG8_MMA(0, 1, At, B1); PG8_BAR; PG8_SCHED;
            PG8_LDA(At, 1, 1); PG8_STAGE(PG8_SB(1, 0), b3, voffB); PG8_STAGE(PG8_SB(1, 1), b3 + hstep, voffB); PG8_STAGE(PG8_SA(1, 0), a3, voffA);
            PG8_WAIT_V(8); PG8_WAIT_L(0); PG8_BAR; PG8_MMA(1, 0, At, B0); PG8_MMA(1, 1, At, B1); PG8_BAR; PG8_SCHED;
            } else {
            PG8_LDB(B0, 0, 0); PG8_SCHED; PG8_LDA(At, 0, 0); PG8_STAGE(PG8_SA(1, 1), a1 + hstep, voffA);
            PG8_WAIT_L(8); PG8_BAR; PG8_WAIT_L(0); PG8_MMA(0, 0, At, B0); PG8_BAR; PG8_SCHED;
            PG8_LDB(B1, 0, 1); PG8_STAGE(PG8_SB(0, 0), b2, voffB);
            PG8_BAR; PG8_WAIT_L(0); PG8_MMA(0, 1, At, B1); PG8_BAR;
            PG8_LDA(At, 0, 1); PG8_STAGE(PG8_SA(0, 0), a2, voffA);
            PG8_BAR; PG8_WAIT_L(0); PG8_MMA(1, 0, At, B0); PG8_BAR; PG8_SCHED;
            PG8_STAGE(PG8_SB(0, 1), b2 + hstep, voffB);
            PG8_WAIT_V(6); PG8_BAR; PG8_MMA(1, 1, At, B1); PG8_BAR;
            PG8_LDB(B0, 1, 0); PG8_SCHED; PG8_LDA(At, 1, 0); PG8_STAGE(PG8_SA(0, 1), a2 + hstep, voffA);
            PG8_WAIT_L(8); PG8_BAR; PG8_WAIT_L(0); PG8_MMA(0, 0, At, B0); PG8_BAR; PG8_SCHED;
            PG8_LDB(B1, 1, 1); PG8_STAGE(PG8_SB(1, 0), b3, voffB);
            PG8_BAR; PG8_WAIT_L(0); PG8_MMA(0, 1, At, B1); PG8_BAR;
            PG8_LDA(At, 1, 1); PG8_STAGE(PG8_SA(1, 0), a3, voffA);
            PG8_BAR; PG8_WAIT_L(0); PG8_MMA(1, 0, At, B0); PG8_BAR; PG8_SCHED;
            PG8_STAGE(PG8_SB(1, 1), b3 + hstep, voffB);
            PG8_WAIT_V(6); PG8_BAR; PG8_MMA(1, 1, At, B1); PG8_BAR;
            }
        }
        if constexpr (ALIGN_EPI) { if (wr == 0) PG8_BAR; }
        if constexpr (!Epi::AFTER_DRAIN) { E(acc, cur, wr, wc, fr, fq); S.done(cur); }
        if (!has_next) break;
#pragma unroll
        for (int a = 0; a < 2; ++a)
#pragma unroll
            for (int b = 0; b < 2; ++b)
#pragma unroll
                for (int m = 0; m < 4; ++m)
#pragma unroll
                    for (int n = 0; n < 2; ++n) acc[a][b][m][n] = (f32x4){0.f, 0.f, 0.f, 0.f};
        cur = nxt; cA = nA; cB = nB; ++ui;
        if constexpr (ALIGN_EPI) { if (wr == 1) PG8_BAR; }
    }
    PG8_WAIT_V(0);
    if constexpr (!ALIGN_EPI) { if (wr == 0) PG8_BAR; }
    PG8_BAR;
    if constexpr (Epi::AFTER_DRAIN) { E.fused(acc, cur, wr, wc, fr, fq, lds, wid, lane); S.done(cur); }
#undef PG8_SA
#undef PG8_SB
#undef PG8_STAGE
#undef PG8_LDA
#undef PG8_LDB
#undef PG8_MMA
#undef PG8_WAIT_V
#undef PG8_WAIT_L
#undef PG8_BAR
#undef PG8_SCHED
}
}

constexpr int DM = 1024, NBP = 4, TP = 4096, NL = 4, NBS = 32, TS = 4;
constexpr int MP = NBP * TP, MS = NBS * TS, MR = MP + MS, MPAD = 16640, NSEQ = NBP + NBS;
constexpr int INC = 3072, FF = 2816, FF2 = 5632, CKW = 31, WINB = 2048;
constexpr int UC_CA = 0, UC_CG = 256, UC_R = 512, UC_AQ = 1536, UC_AK = 2048, UC_AV = 2560;
constexpr int NTHR = 512, NWAVES = 8;
constexpr size_t O_YP = 0, O_YS = O_YP + (size_t)MP * DM, O_CONVP = O_YS + (size_t)MS * DM, O_CONVS = O_CONVP + (size_t)NL * NBP * 30 * 256,
    O_SHP = O_CONVS + (size_t)NL * NBS * 30 * 256, O_SHS = O_SHP + (size_t)NL * NBP * 1024, O_WKVP = O_SHS + (size_t)NL * NBS * 1024,
    O_WKVS = O_WKVP + (size_t)NL * NBP * 4 * 4096, O_KP = O_WKVS + (size_t)NL * NBS * 4 * 4096, O_KS = O_KP + (size_t)NL * NBP * WINB * 512,
    O_VP = O_KS + (size_t)NL * NBS * TS * 512, O_VS = O_VP + (size_t)NL * NBP * WINB * 512, O_END = O_VS + (size_t)NL * NBS * TS * 512;
enum { I_XP = 0, I_XS, I_CP, I_CS, I_CCONV, I_SSHIFT, I_SWKV, I_CK, I_CV, I_WADA, I_BADA, I_GPM, I_GPOM, I_GPF, I_GPOF, I_WIN, I_WOUT, I_CONVW, I_CONVB, I_CLNG, I_CLNB,
       I_MU, I_W0, I_W2, I_A0, I_A2, I_G2, I_KK, I_KA, I_RK, I_LNG, I_LNB, I_RELB, I_WF1, I_WF2, N_IN };
constexpr size_t MiB = 1u << 20;
constexpr size_t WS_CTL = 0, WS_WIN = 1 * MiB, WS_WOUT = WS_WIN + 24 * MiB, WS_WF1 = WS_WOUT + 8 * MiB, WS_WF2 = WS_WF1 + 44 * MiB, WS_MOD = WS_WF2 + 22 * MiB,
    WS_SC = WS_MOD + 4 * MiB, WS_XN = WS_SC + 1 * MiB, WS_U = WS_XN + 34 * MiB, WS_MIX = WS_U + 98 * MiB, WS_T = WS_MIX + 34 * MiB, WS_H = WS_T + 66 * MiB,
    WS_Z = WS_H + 90 * MiB, WS_STR = WS_Z + 17 * MiB  , WS_YR = WS_STR + 7 * 17 * MiB, WS_OP = WS_YR + 17 * MiB  , WS_ML = WS_OP + 96 * MiB, WS_END = WS_ML + 4 * MiB;
constexpr size_t STR_STRIDE = 17 * MiB / 4;
enum { S_W = 0, S_KK, S_KA, S_KP, S_R, S_V, S_G };

typedef unsigned short bf16;
typedef float f32x4 __attribute__((ext_vector_type(4)));
typedef short bf16x8 __attribute__((ext_vector_type(8)));
typedef short s16x4 __attribute__((ext_vector_type(4)));
typedef unsigned u32x4 __attribute__((ext_vector_type(4)));
typedef unsigned u32x2 __attribute__((ext_vector_type(2)));
#define LAS __attribute__((address_space(3)))
__device__ __forceinline__ float bf2f(unsigned b) { return __uint_as_float(b << 16); }
__device__ __forceinline__ unsigned f2bf(float f) { unsigned u = __float_as_uint(f); return (u + 0x7fffu + ((u >> 16) & 1u)) >> 16; }
__device__ __forceinline__ unsigned pk2(float lo, float hi) { return f2bf(lo) | (f2bf(hi) << 16); }
__device__ __forceinline__ float sigmoid_f(float x) { return 1.0f / (1.0f + __expf(-x)); }
__device__ __forceinline__ float wave_sum(float v) {
#pragma unroll
    for (int o = 1; o < 64; o <<= 1) v += __shfl_xor(v, o);
    return v;
}

struct P {
    const float* in[N_IN]; float* out; unsigned char* ws; int layer; int pad;
};
__device__ __forceinline__ bf16* wsb(const P& p, size_t off) { return (bf16*)(p.ws + off); }
__device__ __forceinline__ float* wsf(const P& p, size_t off) { return (float*)(p.ws + off); }
__device__ __forceinline__ const float* modv(const P& p, int l, int s, int j) { return wsf(p, WS_MOD) + ((size_t)(l * NSEQ + s) * 6 + j) * DM; }
__device__ __forceinline__ int seq_of_row(int row) { return row < MP ? (row >> 12) : NBP + ((row - MP) >> 2); }

__device__ __forceinline__ void transpose_item(const float* W, int K, int N, bf16* WT, int drow0, LAS float* scr, int k0, int n0, int lane) {
#pragma unroll 8
    for (int i = 0; i < 32; ++i) { const int kk = 2 * i + (lane >> 5); scr[kk * 33 + (lane & 31)] = W[(size_t)(k0 + kk) * N + n0 + (lane & 31)]; }
    asm volatile("s_waitcnt lgkmcnt(0)" ::: "memory");
    const int c = lane & 7;
#pragma unroll
    for (int j = 0; j < 4; ++j) { const int n = (lane >> 3) + 8 * j; const LAS float* s = scr + (8 * c) * 33 + n;
        u32x4 o; o.x = pk2(s[0 * 33], s[1 * 33]); o.y = pk2(s[2 * 33], s[3 * 33]); o.z = pk2(s[4 * 33], s[5 * 33]); o.w = pk2(s[6 * 33], s[7 * 33]);
        *(u32x4*)(WT + (size_t)(drow0 + n) * K + k0 + 8 * c) = o; }
    asm volatile("s_waitcnt lgkmcnt(0)" ::: "memory");
}
__global__ void __launch_bounds__(NTHR, 2) k_transpose(P p) {
    extern __shared__ __attribute__((aligned(16))) unsigned char lds[];
    const int tid = threadIdx.x, lane = tid & 63, wave = tid >> 6;
    LAS float* scr = (LAS float*)((LAS unsigned char*)lds + wave * 8704);
    const int gw = blockIdx.x * NWAVES + wave, NGW = gridDim.x * NWAVES;
    constexpr int I_A = 16 * (INC / 32), I_B = 16 * (DM / 32), I_C = 16 * (FF2 / 32), I_D = (FF / 64) * (DM / 32), I_L = I_A + I_B + I_C + I_D;
    for (int it = gw; it < NL * I_L; it += NGW) {
        const int l = it / I_L; int r = it % I_L;
        if (r < I_A) { const int nb = INC / 32, kb = r / nb, n0 = 32 * (r % nb); transpose_item(p.in[I_WIN] + (size_t)l * DM * INC, DM, INC, wsb(p, WS_WIN) + (size_t)l * INC * DM, n0, scr, 64 * kb, n0, lane); continue; } r -= I_A;
        if (r < I_B) { const int nb = DM / 32, kb = r / nb, n0 = 32 * (r % nb); transpose_item(p.in[I_WOUT] + (size_t)l * DM * DM, DM, DM, wsb(p, WS_WOUT) + (size_t)l * DM * DM, n0, scr, 64 * kb, n0, lane); continue; } r -= I_B;
        if (r < I_C) { const int nb = FF2 / 32, kb = r / nb, n0 = 32 * (r % nb);
            const int f = n0 < FF ? n0 : n0 - FF; const int drow0 = (f / 128) * 256 + (n0 < FF ? 0 : 128) + (f % 128);
            transpose_item(p.in[I_WF1] + (size_t)l * DM * FF2, DM, FF2, wsb(p, WS_WF1) + (size_t)l * FF2 * DM, drow0, scr, 64 * kb, n0, lane); continue; } r -= I_C;
        { const int nb = DM / 32, kb = r / nb, n0 = 32 * (r % nb); transpose_item(p.in[I_WF2] + (size_t)l * FF * DM, FF, DM, wsb(p, WS_WF2) + (size_t)l * DM * FF, n0, scr, 64 * kb, n0, lane); }
    }
}
__global__ void k_silu(P p) {
    const int i = blockIdx.x * blockDim.x + threadIdx.x;
    if (i < NSEQ * DM) { const int s = i / DM, k = i % DM; const float c = s < NBP ? p.in[I_CP][s * DM + k] : p.in[I_CS][(s - NBP) * DM + k]; wsf(p, WS_SC)[i] = c * sigmoid_f(c); }
}
__global__ void __launch_bounds__(NTHR, 2) k_mod(P p) {
    extern __shared__ __attribute__((aligned(16))) unsigned char lds[];
    LAS float* red = (LAS float*)lds;
    const int tid = threadIdx.x, lane = tid & 63, wave = tid >> 6;
    const float* SC = wsf(p, WS_SC);
    for (int it = blockIdx.x; it < NL * 96; it += gridDim.x) {
        const int l = it / 96, col = (it % 96) * 64 + lane;
        float acc[NSEQ];
#pragma unroll
        for (int s = 0; s < NSEQ; ++s) acc[s] = 0.f;
        const float* W = p.in[I_WADA] + (size_t)l * DM * 6144 + col;
        for (int k = wave * 128; k < wave * 128 + 128; ++k) { const float w = W[(size_t)k * 6144];
#pragma unroll
            for (int s = 0; s < NSEQ; ++s) acc[s] += SC[s * DM + k] * w; }
#pragma unroll
        for (int s = 0; s < NSEQ; ++s) red[(wave * NSEQ + s) * 64 + lane] = acc[s];
        __syncthreads();
        for (int e = tid; e < NSEQ * 64; e += NTHR) { const int s = e >> 6, c = e & 63; float v = 0.f;
#pragma unroll
            for (int w = 0; w < 8; ++w) v += red[(w * NSEQ + s) * 64 + c];
            const int cc = (it % 96) * 64 + c; wsf(p, WS_MOD)[(size_t)(l * NSEQ + s) * 6144 + cc] = v + p.in[I_BADA][l * 6144 + cc]; }
        __syncthreads();
    }
}
__device__ __forceinline__ void norm_row_bf16(const float* xrow, const float* g, const float* scale, const float* shift, bf16* orow, int lane) {
    const f32x4* xr = (const f32x4*)xrow + lane; f32x4 v[4]; float s = 0.f;
#pragma unroll
    for (int j = 0; j < 4; ++j) { v[j] = xr[64 * j]; s += (v[j].x * v[j].x + v[j].y * v[j].y) + (v[j].z * v[j].z + v[j].w * v[j].w); }
    const float rstd = 1.0f / sqrtf(wave_sum(s) * (1.0f / DM) + 1e-6f);
#pragma unroll
    for (int j = 0; j < 4; ++j) { const int c = 4 * lane + 256 * j; const f32x4 gg = *(const f32x4*)(g + c), sc = *(const f32x4*)(scale + c), sh = *(const f32x4*)(shift + c);
        f32x4 o; o.x = v[j].x * rstd * gg.x * (1.f + sc.x) + sh.x; o.y = v[j].y * rstd * gg.y * (1.f + sc.y) + sh.y; o.z = v[j].z * rstd * gg.z * (1.f + sc.z) + sh.z; o.w = v[j].w * rstd * gg.w * (1.f + sc.w) + sh.w;
        u32x2 w; w.x = pk2(o.x, o.y); w.y = pk2(o.z, o.w); *(u32x2*)(orow + c) = w; }
}
__global__ void __launch_bounds__(NTHR, 2) k_norm0(P p) {
    const int lane = threadIdx.x & 63, gw = blockIdx.x * NWAVES + (threadIdx.x >> 6), NGW = gridDim.x * NWAVES;
    for (int row = gw; row < MR; row += NGW) { const int s = seq_of_row(row);
        const float* x = row < MP ? p.in[I_XP] + (size_t)row * DM : p.in[I_XS] + (size_t)(row - MP) * DM;
        norm_row_bf16(x, p.in[I_GPM], modv(p, 0, s, 1), modv(p, 0, s, 0), wsb(p, WS_XN) + (size_t)row * DM, lane); }
}
__global__ void __launch_bounds__(NTHR, 2) k_resid(P p, int which) {
    const int l = p.layer, lane = threadIdx.x & 63, gw = blockIdx.x * NWAVES + (threadIdx.x >> 6), NGW = gridDim.x * NWAVES;
    for (int row = gw; row < MR; row += NGW) { const int s = seq_of_row(row);
        const float* xin = (l == 0 && which == 0) ? (row < MP ? p.in[I_XP] + (size_t)row * DM : p.in[I_XS] + (size_t)(row - MP) * DM) : p.out + (size_t)row * DM;
        float* xout = p.out + (size_t)row * DM;
        const float* t = wsf(p, WS_T) + (size_t)row * DM;
        const float* gpost = p.in[which == 0 ? I_GPOM : I_GPOF] + l * DM; const float* gate = modv(p, l, s, which == 0 ? 2 : 5);
        f32x4 tv[4], xv[4]; float ss = 0.f;
#pragma unroll
        for (int j = 0; j < 4; ++j) { tv[j] = ((const f32x4*)t)[lane + 64 * j]; xv[j] = ((const f32x4*)xin)[lane + 64 * j]; ss += (tv[j].x * tv[j].x + tv[j].y * tv[j].y) + (tv[j].z * tv[j].z + tv[j].w * tv[j].w); }
        const float rstd = 1.0f / sqrtf(wave_sum(ss) * (1.0f / DM) + 1e-6f); float s2 = 0.f;
#pragma unroll
        for (int j = 0; j < 4; ++j) { const int c = 4 * lane + 256 * j; const f32x4 gp = *(const f32x4*)(gpost + c), ga = *(const f32x4*)(gate + c);
            xv[j].x += ga.x * (tv[j].x * rstd * gp.x); xv[j].y += ga.y * (tv[j].y * rstd * gp.y); xv[j].z += ga.z * (tv[j].z * rstd * gp.z); xv[j].w += ga.w * (tv[j].w * rstd * gp.w);
            ((f32x4*)xout)[lane + 64 * j] = xv[j]; s2 += (xv[j].x * xv[j].x + xv[j].y * xv[j].y) + (xv[j].z * xv[j].z + xv[j].w * xv[j].w); }
        if (which == 1 && l == NL - 1) continue;
        const int ln = which == 0 ? l : l + 1;
        const float* gn = p.in[which == 0 ? I_GPF : I_GPM] + ln * DM; const float* sc = modv(p, ln, s, which == 0 ? 4 : 1); const float* sh = modv(p, ln, s, which == 0 ? 3 : 0);
        const float rstd2 = 1.0f / sqrtf(wave_sum(s2) * (1.0f / DM) + 1e-6f); bf16* orow = wsb(p, WS_XN) + (size_t)row * DM;
#pragma unroll
        for (int j = 0; j < 4; ++j) { const int c = 4 * lane + 256 * j; const f32x4 gg = *(const f32x4*)(gn + c), s_ = *(const f32x4*)(sc + c), h_ = *(const f32x4*)(sh + c);
            u32x2 w; w.x = pk2(xv[j].x * rstd2 * gg.x * (1.f + s_.x) + h_.x, xv[j].y * rstd2 * gg.y * (1.f + s_.y) + h_.y); w.y = pk2(xv[j].z * rstd2 * gg.z * (1.f + s_.z) + h_.z, xv[j].w * rstd2 * gg.w * (1.f + s_.w) + h_.w);
            *(u32x2*)(orow + c) = w; }
    }
}

template <int WHICH> __global__ void __launch_bounds__(NTHR, 2) k_gemm(P p) {
    extern __shared__ __attribute__((aligned(16))) unsigned char lds[];
    const int l = p.layer; pg8::StaticOrder S;
    if constexpr (WHICH == 0) { pg8::Gemm g{wsb(p, WS_XN), wsb(p, WS_WIN) + (size_t)l * INC * DM, MPAD, INC, DM}; S.init(MPAD, INC, gridDim.x, blockIdx.x);
        pg8::EpiBf16 E{wsb(p, WS_U), INC}; pg8::gemm_phase<pg8::EpiBf16, pg8::StaticOrder, true, true>((LAS unsigned char*)lds, g, S, E); }
    if constexpr (WHICH == 1) { pg8::Gemm g{wsb(p, WS_MIX), wsb(p, WS_WOUT) + (size_t)l * DM * DM, MPAD, DM, DM}; S.init(MPAD, DM, gridDim.x, blockIdx.x);
        pg8::EpiF32 E{wsf(p, WS_T), DM}; pg8::gemm_phase<pg8::EpiF32, pg8::StaticOrder, true, true>((LAS unsigned char*)lds, g, S, E); }
    if constexpr (WHICH == 2) { pg8::Gemm g{wsb(p, WS_XN), wsb(p, WS_WF1) + (size_t)l * FF2 * DM, MPAD, FF2, DM}; S.init(MPAD, FF2, gridDim.x, blockIdx.x);
        pg8::EpiSwiGLU E{wsb(p, WS_H), FF}; pg8::gemm_phase<pg8::EpiSwiGLU, pg8::StaticOrder, true, true>((LAS unsigned char*)lds, g, S, E); }
    if constexpr (WHICH == 3) { pg8::Gemm g{wsb(p, WS_H), wsb(p, WS_WF2) + (size_t)l * DM * FF, MPAD, DM, FF}; S.init(MPAD, DM, gridDim.x, blockIdx.x);
        pg8::EpiF32 E{wsf(p, WS_T), DM}; pg8::gemm_phase<pg8::EpiF32, pg8::StaticOrder, true, true>((LAS unsigned char*)lds, g, S, E); }
}

__global__ void __launch_bounds__(NTHR, 2) k_glu(P p) {
    const int l = p.layer; const bf16* U = wsb(p, WS_U); float* Z = wsf(p, WS_Z);
    const int gt = blockIdx.x * NTHR + threadIdx.x, NT = gridDim.x * NTHR;
    for (int idx = gt; idx < MR * 64; idx += NT) { const int row = idx >> 6, c4 = (idx & 63) * 4;
        const u32x2 a = *(const u32x2*)(U + (size_t)row * INC + UC_CA + c4), g = *(const u32x2*)(U + (size_t)row * INC + UC_CG + c4);
        f32x4 z; z.x = bf2f(a.x & 0xffffu) * sigmoid_f(bf2f(g.x & 0xffffu)); z.y = bf2f(a.x >> 16) * sigmoid_f(bf2f(g.x >> 16)); z.z = bf2f(a.y & 0xffffu) * sigmoid_f(bf2f(g.y & 0xffffu)); z.w = bf2f(a.y >> 16) * sigmoid_f(bf2f(g.y >> 16));
        *(f32x4*)(Z + (size_t)row * 256 + c4) = z;
        if (row < MP) { const int n = row >> 12, t = row & 4095; if (t >= TP - 30) *(f32x4*)(p.out + O_CONVP + ((size_t)(l * NBP + n) * 30 + (t - (TP - 30))) * 256 + c4) = z; }
        else { const int rs = row - MP, n = rs >> 2, s = rs & 3; *(f32x4*)(p.out + O_CONVS + ((size_t)(l * NBS + n) * 30 + 26 + s) * 256 + c4) = z; }
    }
    for (int idx = gt; idx < NBS * 26 * 64; idx += NT) { const int n = idx / (26 * 64), r = idx % (26 * 64), i = r >> 6, c4 = (r & 63) * 4;
        *(f32x4*)(p.out + O_CONVS + ((size_t)(l * NBS + n) * 30 + i) * 256 + c4) = *(const f32x4*)(p.in[I_CCONV] + ((size_t)(l * NBS + n) * 30 + i + 4) * 256 + c4); }
}
__global__ void __launch_bounds__(NTHR, 2) k_conv(P p) {
    __shared__ float red[2][2][4];
    const int l = p.layer, tid = threadIdx.x, c = tid & 255, half = tid >> 8, wv = (tid >> 6) & 3, lane = tid & 63;
    const float* Z = wsf(p, WS_Z); const float* cw = p.in[I_CONVW] + (size_t)l * CKW * 256 + c;
    float w[CKW];
#pragma unroll
    for (int j = 0; j < CKW; ++j) w[j] = cw[j * 256];
    const float cb = p.in[I_CONVB][l * 256 + c], lg = p.in[I_CLNG][l * 256 + c], lb = p.in[I_CLNB][l * 256 + c];
    for (int pr = blockIdx.x; pr < MR / 2; pr += gridDim.x) { const int row = 2 * pr + half; float acc = cb;
        if (row < MP) { const int t = row & 4095;
#pragma unroll
            for (int j = 0; j < CKW; ++j) { const int tau = t + j - 30; if (tau >= 0) acc += w[j] * Z[(size_t)(row + j - 30) * 256 + c]; } }
        else { const int rs = row - MP, n = rs >> 2, s = rs & 3;
#pragma unroll
            for (int j = 0; j < CKW; ++j) { const int tau = s + j - 30; const float z = tau >= 0 ? Z[(size_t)(MP + n * 4 + tau) * 256 + c] : p.in[I_CCONV][((size_t)(l * NBS + n) * 30 + 30 + tau) * 256 + c]; acc += w[j] * z; } }
        float s1 = wave_sum(acc); if (lane == 0) red[0][half][wv] = s1; __syncthreads();
        const float mean = (red[0][half][0] + red[0][half][1] + red[0][half][2] + red[0][half][3]) * (1.f / 256.f); const float d = acc - mean;
        float s2 = wave_sum(d * d); if (lane == 0) red[1][half][wv] = s2; __syncthreads();
        const float var = (red[1][half][0] + red[1][half][1] + red[1][half][2] + red[1][half][3]) * (1.f / 256.f);
        const float y = d * (1.0f / sqrtf(var + 1e-5f)) * lg + lb;
        wsb(p, WS_MIX)[(size_t)row * DM + c] = (bf16)f2bf(y * sigmoid_f(y));
        __syncthreads();
    }
}
__global__ void __launch_bounds__(NTHR, 2) k_rwkv_prep(P p) {
    extern __shared__ __attribute__((aligned(16))) unsigned char lds[];
    LAS float* xs = (LAS float*)lds;
    const int l = p.layer, tid = threadIdx.x, c = tid & 255, half = tid >> 8;
    const bf16* U = wsb(p, WS_U); const float* mu = p.in[I_MU] + l * 1024; float* STR = wsf(p, WS_STR);
    for (int grp = blockIdx.x; grp < MR / 16; grp += gridDim.x) {
        for (int i = 0; i < 32; ++i) { const int e = tid + NTHR * i, tok = e >> 10, col = e & 1023, row = grp * 16 + tok;
            const float u = bf2f(U[(size_t)row * INC + UC_R + col]); float pv;
            if (row < MP) pv = (row & 4095) == 0 ? 0.f : bf2f(U[(size_t)(row - 1) * INC + UC_R + col]);
            else { const int rs = row - MP; pv = (rs & 3) == 0 ? p.in[I_SSHIFT][(size_t)(l * NBS + (rs >> 2)) * 1024 + col] : bf2f(U[(size_t)(row - 1) * INC + UC_R + col]); }
            float x = u + (pv - u) * mu[col];
            if (col >= 768 && col < 832) x = tanhf(x); else if (col >= 896) x = sigmoid_f(x);
            xs[e] = x; }
        __syncthreads();
        float aw[8], aa[8], ag[8];
#pragma unroll
        for (int t = 0; t < 8; ++t) { aw[t] = 0.f; aa[t] = 0.f; ag[t] = 0.f; }
        const float* w2 = p.in[I_W2] + (size_t)l * 64 * 256 + c; const float* a2 = p.in[I_A2] + (size_t)l * 64 * 256 + c; const float* g2 = p.in[I_G2] + (size_t)l * 128 * 256 + c;
        for (int k = 0; k < 64; ++k) { const float wv = w2[k * 256], av = a2[k * 256];
#pragma unroll
            for (int t = 0; t < 8; ++t) { aw[t] += xs[(half * 8 + t) * 1024 + 768 + k] * wv; aa[t] += xs[(half * 8 + t) * 1024 + 832 + k] * av; } }
        for (int k = 0; k < 128; ++k) { const float gv = g2[k * 256];
#pragma unroll
            for (int t = 0; t < 8; ++t) ag[t] += xs[(half * 8 + t) * 1024 + 896 + k] * gv; }
        const float w0 = p.in[I_W0][l * 256 + c], a0 = p.in[I_A0][l * 256 + c], kkw = p.in[I_KK][l * 256 + c], kaw = p.in[I_KA][l * 256 + c];
#pragma unroll
        for (int t = 0; t < 8; ++t) { const int tok = half * 8 + t, row = grp * 16 + tok;
            const float r = xs[tok * 1024 + c], k = xs[tok * 1024 + 256 + c], v = xs[tok * 1024 + 512 + c];
            const float wlog = -0.6065306597126334f * sigmoid_f(w0 + aw[t]); const float a = sigmoid_f(a0 + aa[t]);
            float kk = k * kkw; const float nrm = sqrtf(wave_sum(kk * kk)); kk = kk / fmaxf(nrm, 1e-12f);
            const float kp = k * (1.0f + (a - 1.0f) * kaw);
            const size_t o = (size_t)row * 256 + c;
            STR[S_W * STR_STRIDE + o] = __expf(wlog); STR[S_KK * STR_STRIDE + o] = kk; STR[S_KA * STR_STRIDE + o] = kk * a; STR[S_KP * STR_STRIDE + o] = kp;
            STR[S_R * STR_STRIDE + o] = r; STR[S_V * STR_STRIDE + o] = v; STR[S_G * STR_STRIDE + o] = ag[t]; }
        __syncthreads();
    }
}
__global__ void __launch_bounds__(64) k_rwkv_scan(P p) {
    __shared__ __attribute__((aligned(16))) float st[5][8][64];
    const int l = p.layer, unit = blockIdx.x, seq = unit >> 2, h = unit & 3, lane = threadIdx.x;
    const float* STR = wsf(p, WS_STR); float* YR = wsf(p, WS_YR);
    const int row0 = seq < NBP ? seq * TP : MP + (seq - NBP) * TS, nsteps = seq < NBP ? TP : TS;
    float S[64];
    if (seq < NBP) {
#pragma unroll
        for (int k = 0; k < 64; ++k) S[k] = 0.f;
    } else { const float* s0 = p.in[I_SWKV] + ((size_t)((l * NBS + (seq - NBP)) * 4 + h) * 64 + lane) * 64;
#pragma unroll
        for (int k = 0; k < 64; ++k) S[k] = s0[k]; }
    for (int t0 = 0; t0 < nsteps; t0 += 8) {
        float vv[8];
#pragma unroll
        for (int i = 0; i < 8; ++i) { const bool ok = t0 + i < nsteps; const size_t o = (size_t)(row0 + (ok ? t0 + i : 0)) * 256 + h * 64 + lane;
            st[0][i][lane] = STR[S_W * STR_STRIDE + o]; st[1][i][lane] = STR[S_KK * STR_STRIDE + o]; st[2][i][lane] = STR[S_KA * STR_STRIDE + o];
            st[3][i][lane] = STR[S_KP * STR_STRIDE + o]; st[4][i][lane] = STR[S_R * STR_STRIDE + o]; vv[i] = STR[S_V * STR_STRIDE + o]; }
        __syncthreads();
#pragma unroll
        for (int i = 0; i < 8; ++i) { if (t0 + i < nsteps) {
            float d0 = 0.f, d1 = 0.f;
#pragma unroll
            for (int k = 0; k < 64; k += 4) { const f32x4 q = *(const f32x4*)&st[1][i][k]; d0 += S[k] * q.x; d1 += S[k + 1] * q.y; d0 += S[k + 2] * q.z; d1 += S[k + 3] * q.w; }
            const float d = d0 + d1, v = vv[i]; float y0 = 0.f, y1 = 0.f;
#pragma unroll
            for (int k = 0; k < 64; k += 4) { const f32x4 w = *(const f32x4*)&st[0][i][k], ka = *(const f32x4*)&st[2][i][k], kp = *(const f32x4*)&st[3][i][k], r = *(const f32x4*)&st[4][i][k];
                S[k] = S[k] * w.x - d * ka.x + v * kp.x; S[k + 1] = S[k + 1] * w.y - d * ka.y + v * kp.y; S[k + 2] = S[k + 2] * w.z - d * ka.z + v * kp.z; S[k + 3] = S[k + 3] * w.w - d * ka.w + v * kp.w;
                y0 += S[k] * r.x; y1 += S[k + 1] * r.y; y0 += S[k + 2] * r.z; y1 += S[k + 3] * r.w; }
            YR[(size_t)(row0 + t0 + i) * 256 + h * 64 + lane] = y0 + y1; } }
        __syncthreads();
    }
    float* so = p.out + (seq < NBP ? O_WKVP + ((size_t)((l * NBP + seq) * 4 + h) * 64 + lane) * 64 : O_WKVS + ((size_t)((l * NBS + (seq - NBP)) * 4 + h) * 64 + lane) * 64);
#pragma unroll
    for (int k = 0; k < 64; k += 4) *(f32x4*)(so + k) = (f32x4){S[k], S[k + 1], S[k + 2], S[k + 3]};
}
__global__ void __launch_bounds__(NTHR, 2) k_rwkv_post(P p) {
    const int l = p.layer, lane = threadIdx.x & 63, gw = blockIdx.x * NWAVES + (threadIdx.x >> 6), NGW = gridDim.x * NWAVES;
    const float* STR = wsf(p, WS_STR); const float* YR = wsf(p, WS_YR);
    for (int u = gw; u < MR * 4; u += NGW) { const int row = u >> 2, h = u & 3, c = h * 64 + lane; const size_t o = (size_t)row * 256 + c;
        const float y = YR[o], mean = wave_sum(y) * (1.f / 64.f), d = y - mean, var = wave_sum(d * d) * (1.f / 64.f);
        const float yn = d * (1.0f / sqrtf(var + 64e-5f)) * p.in[I_LNG][l * 256 + c] + p.in[I_LNB][l * 256 + c];
        const float bon = wave_sum(STR[S_R * STR_STRIDE + o] * STR[S_KP * STR_STRIDE + o] * p.in[I_RK][l * 256 + c]) * STR[S_V * STR_STRIDE + o];
        wsb(p, WS_MIX)[(size_t)row * DM + 256 + c] = (bf16)f2bf((yn + bon) * STR[S_G * STR_STRIDE + o]); }
}
__global__ void __launch_bounds__(NTHR, 2) k_copy_out(P p) {
    const int l = p.layer; const bf16* U = wsb(p, WS_U); const int gt = blockIdx.x * NTHR + threadIdx.x, NT = gridDim.x * NTHR;
    for (int idx = gt; idx < NBP * WINB * 256; idx += NT) { const int c4 = (idx & 255) * 4, i = (idx >> 8) & 2047, n = idx >> 19;
        const int isv = c4 >= 512, cc = c4 & 511; const u32x2 a = *(const u32x2*)(U + (size_t)(n * TP + (TP - WINB) + i) * INC + (isv ? UC_AV : UC_AK) + cc);
        *(f32x4*)(p.out + (isv ? O_VP : O_KP) + ((size_t)(l * NBP + n) * WINB + i) * 512 + cc) = (f32x4){bf2f(a.x & 0xffffu), bf2f(a.x >> 16), bf2f(a.y & 0xffffu), bf2f(a.y >> 16)}; }
    for (int idx = gt; idx < MS * 256; idx += NT) { const int c4 = (idx & 255) * 4, rs = idx >> 8; const int isv = c4 >= 512, cc = c4 & 511;
        const u32x2 a = *(const u32x2*)(U + (size_t)(MP + rs) * INC + (isv ? UC_AV : UC_AK) + cc);
        *(f32x4*)(p.out + (isv ? O_VS : O_KS) + ((size_t)l * MS + rs) * 512 + cc) = (f32x4){bf2f(a.x & 0xffffu), bf2f(a.x >> 16), bf2f(a.y & 0xffffu), bf2f(a.y >> 16)}; }
    for (int idx = gt; idx < NSEQ * 256; idx += NT) { const int c4 = (idx & 255) * 4, s = idx >> 8; const int row = s < NBP ? s * TP + TP - 1 : MP + (s - NBP) * TS + TS - 1;
        const u32x2 a = *(const u32x2*)(U + (size_t)row * INC + UC_R + c4);
        float* o = s < NBP ? p.out + O_SHP + (size_t)(l * NBP + s) * 1024 + c4 : p.out + O_SHS + (size_t)(l * NBS + (s - NBP)) * 1024 + c4;
        *(f32x4*)o = (f32x4){bf2f(a.x & 0xffffu), bf2f(a.x >> 16), bf2f(a.y & 0xffffu), bf2f(a.y >> 16)}; }
}
__device__ __forceinline__ int rel_bucket(int dist) {
    if (dist < 16) return dist;
    const float d = (float)dist; int lg = 16 + (int)(logf(d / 16.0f) / logf(128.0f) * 16.0f); return lg < 31 ? lg : 31;
}
__global__ void __launch_bounds__(NTHR, 2) k_attn_p(P p) {
    extern __shared__ __attribute__((aligned(16))) unsigned char lds[];
    LAS float* btab = (LAS float*)lds;
    constexpr int VROW = 144, VB = 32 * VROW;
    const int tid = threadIdx.x, lane = tid & 63, wave = tid >> 6, fr = lane & 15, g = lane >> 4;
    LAS unsigned char* vst = (LAS unsigned char*)lds + 3 * 129 * 8 * 4 + wave * VB;
    for (int e = tid; e < 3 * 129; e += NTHR) { const int br = e / 129, dl = e % 129, dil = br == 0 ? 1 : (br == 1 ? 4 : 16); const int b = rel_bucket(dl * dil);
        for (int h = 0; h < 8; ++h) btab[e * 8 + h] = p.in[I_RELB][b * 8 + h]; }
    __syncthreads();
    const bf16* U = wsb(p, WS_U); float* OP = wsf(p, WS_OP); float* ML = wsf(p, WS_ML);
    const int gw = blockIdx.x * NWAVES + wave, NGW = gridDim.x * NWAVES;
    for (int u = gw; u < 3 * NBP * 8 * 256; u += NGW) {
        const int br = u / 8192, rem = u % 8192, n = rem / 2048, h = (rem % 2048) / 256, rq = rem % 256;
        const int dil = br == 0 ? 1 : (br == 1 ? 4 : 16), tpr = 256 / dil, r = rq / tpr, qt = rq % tpr, j0 = 16 * qt, L = TP / dil;
        const size_t rowb = (size_t)n * TP;
        bf16x8 qf[2];
        { const bf16* qp = U + (rowb + (size_t)(j0 + fr) * dil + r) * INC + UC_AQ + h * 64 + 8 * g; qf[0] = *(const bf16x8*)qp; qf[1] = *(const bf16x8*)(qp + 32); }
        float sc[9][4]; float mx = -1e30f;
#pragma unroll
        for (int kt = 0; kt < 9; ++kt) {
            int kj = j0 - 128 + 16 * kt + fr; kj = kj < 0 ? 0 : kj;
            const bf16* kp = U + (rowb + (size_t)kj * dil + r) * INC + UC_AK + h * 64 + 8 * g;
            const bf16x8 k0 = *(const bf16x8*)kp, k1 = *(const bf16x8*)(kp + 32);
            f32x4 acc = {0.f, 0.f, 0.f, 0.f};
            acc = __builtin_amdgcn_mfma_f32_16x16x32_bf16(k0, qf[0], acc, 0, 0, 0);
            acc = __builtin_amdgcn_mfma_f32_16x16x32_bf16(k1, qf[1], acc, 0, 0, 0);
#pragma unroll
            for (int rg = 0; rg < 4; ++rg) { const int kjr = j0 - 128 + 16 * kt + 4 * g + rg, dl = j0 + fr - kjr; const bool ok = dl >= 0 && dl <= 128 && kjr >= 0;
                const float s = ok ? acc[rg] * 0.125f + btab[(br * 129 + (ok ? dl : 0)) * 8 + h] : -1e30f; sc[kt][rg] = s; mx = fmaxf(mx, s); }
        }
        mx = fmaxf(mx, __shfl_xor(mx, 16)); mx = fmaxf(mx, __shfl_xor(mx, 32));
        float lsum = 0.f;
#pragma unroll
        for (int kt = 0; kt < 9; ++kt)
#pragma unroll
            for (int rg = 0; rg < 4; ++rg) { const float e = __expf(sc[kt][rg] - mx); sc[kt][rg] = e; lsum += e; }
        lsum += __shfl_xor(lsum, 16); lsum += __shfl_xor(lsum, 32);
        f32x4 o[4];
#pragma unroll
        for (int dt = 0; dt < 4; ++dt) o[dt] = (f32x4){0.f, 0.f, 0.f, 0.f};
#pragma unroll
        for (int ks = 0; ks < 5; ++ks) {
#pragma unroll
            for (int i4 = 0; i4 < 4; ++i4) { const int ri = (lane >> 3) + 8 * i4; int kj = j0 - 128 + 32 * ks + ri; kj = kj < 0 ? 0 : (kj > L - 1 ? L - 1 : kj);
                const u32x4 v = *(const u32x4*)(U + (rowb + (size_t)kj * dil + r) * INC + UC_AV + h * 64 + (lane & 7) * 8);
                *(LAS u32x4*)(vst + ri * VROW + (lane & 7) * 16) = v; }
            asm volatile("s_waitcnt lgkmcnt(0)" ::: "memory");
            bf16x8 pf;
            { const unsigned a0 = pk2(sc[2 * ks][0], sc[2 * ks][1]), a1 = pk2(sc[2 * ks][2], sc[2 * ks][3]);
              unsigned a2 = 0u, a3 = 0u; if (ks < 4) { a2 = pk2(sc[2 * ks + 1 < 9 ? 2 * ks + 1 : 8][0], sc[2 * ks + 1 < 9 ? 2 * ks + 1 : 8][1]); a3 = pk2(sc[2 * ks + 1 < 9 ? 2 * ks + 1 : 8][2], sc[2 * ks + 1 < 9 ? 2 * ks + 1 : 8][3]); }
              const u32x4 t = {a0, a1, a2, a3}; pf = __builtin_bit_cast(bf16x8, t); }
#pragma unroll
            for (int dt = 0; dt < 4; ++dt) {
                LAS unsigned char* a = vst + (4 * g + (fr >> 2)) * VROW + (16 * dt + 4 * (fr & 3)) * 2;
                const s16x4 lo = __builtin_bit_cast(s16x4, __builtin_amdgcn_ds_read_tr16_b64_v4i16((LAS s16x4*)a));
                const s16x4 hi = __builtin_bit_cast(s16x4, __builtin_amdgcn_ds_read_tr16_b64_v4i16((LAS s16x4*)(a + 16 * VROW)));
                const bf16x8 vf = {lo[0], lo[1], lo[2], lo[3], hi[0], hi[1], hi[2], hi[3]};
                o[dt] = __builtin_amdgcn_mfma_f32_16x16x32_bf16(pf, vf, o[dt], 0, 0, 0); }
            asm volatile("s_waitcnt lgkmcnt(0)" ::: "memory");
        }
#pragma unroll
        for (int rg = 0; rg < 4; ++rg) { const size_t row = rowb + (size_t)(j0 + 4 * g + rg) * dil + r;
#pragma unroll
            for (int dt = 0; dt < 4; ++dt) OP[((size_t)br * MP + row) * 512 + h * 64 + 16 * dt + fr] = o[dt][rg]; }
        if (g == 0) { const size_t row = rowb + (size_t)(j0 + fr) * dil + r; float* ml = ML + (((size_t)br * MP + row) * 8 + h) * 2; ml[0] = mx; ml[1] = lsum; }
    }
}
__global__ void __launch_bounds__(NTHR, 2) k_attn_merge(P p) {
    const float* OP = wsf(p, WS_OP); const float* ML = wsf(p, WS_ML); const int gt = blockIdx.x * NTHR + threadIdx.x, NT = gridDim.x * NTHR;
    for (int idx = gt; idx < MP * 128; idx += NT) { const int row = idx >> 7, c4 = (idx & 127) * 4, h = c4 >> 6;
        float m[3], l[3]; float M = -1e30f;
#pragma unroll
        for (int b = 0; b < 3; ++b) { m[b] = ML[(((size_t)b * MP + row) * 8 + h) * 2]; l[b] = ML[(((size_t)b * MP + row) * 8 + h) * 2 + 1]; M = fmaxf(M, m[b]); }
        f32x4 num = {0.f, 0.f, 0.f, 0.f}; float den = 0.f;
#pragma unroll
        for (int b = 0; b < 3; ++b) { const float w = __expf(m[b] - M); den += w * l[b]; num += *(const f32x4*)(OP + ((size_t)b * MP + row) * 512 + c4) * w; }
        const float inv = 1.0f / den; u32x2 w; w.x = pk2(num.x * inv, num.y * inv); w.y = pk2(num.z * inv, num.w * inv);
        *(u32x2*)(wsb(p, WS_MIX) + (size_t)row * DM + 512 + c4) = w; }
}
__global__ void __launch_bounds__(NTHR, 2) k_attn_s(P p) {
    const int l = p.layer, lane = threadIdx.x & 63, sub = lane & 15, ks = lane >> 4, gw = blockIdx.x * NWAVES + (threadIdx.x >> 6), NGW = gridDim.x * NWAVES;
    const bf16* U = wsb(p, WS_U);
    for (int u = gw; u < NBS * TS * 8; u += NGW) { const int h = u & 7, s = (u >> 3) & 3, n = u >> 5; const int row = MP + n * TS + s;
        f32x4 q; { const u32x2 a = *(const u32x2*)(U + (size_t)row * INC + UC_AQ + h * 64 + 4 * sub); q = (f32x4){bf2f(a.x & 0xffffu), bf2f(a.x >> 16), bf2f(a.y & 0xffffu), bf2f(a.y >> 16)}; }
        float mr = -1e30f, lr = 0.f; f32x4 o = {0.f, 0.f, 0.f, 0.f};
#pragma unroll 1
        for (int br = 0; br < 3; ++br) { const int dil = br == 0 ? 1 : (br == 1 ? 4 : 16);
#pragma unroll 1
            for (int it = 0; it < 33; ++it) { const int m = 4 * it + ks; const bool ok = m <= 128; const int idx = WINB + s - (ok ? m : 0) * dil;
                f32x4 kv, vv;
                if (idx >= WINB) { const size_t ro = (size_t)(MP + n * TS + (idx - WINB)) * INC + h * 64 + 4 * sub; const u32x2 a = *(const u32x2*)(U + ro + UC_AK), b = *(const u32x2*)(U + ro + UC_AV);
                    kv = (f32x4){bf2f(a.x & 0xffffu), bf2f(a.x >> 16), bf2f(a.y & 0xffffu), bf2f(a.y >> 16)}; vv = (f32x4){bf2f(b.x & 0xffffu), bf2f(b.x >> 16), bf2f(b.y & 0xffffu), bf2f(b.y >> 16)}; }
                else { const size_t co = (((size_t)(l * NBS + n) * WINB + idx) * 8 + h) * 64 + 4 * sub; kv = *(const f32x4*)(p.in[I_CK] + co); vv = *(const f32x4*)(p.in[I_CV] + co); }
                float d = (q.x * kv.x + q.y * kv.y) + (q.z * kv.z + q.w * kv.w);
                d += __shfl_xor(d, 1); d += __shfl_xor(d, 2); d += __shfl_xor(d, 4); d += __shfl_xor(d, 8);
                if (ok) { const float sc = d * 0.125f + p.in[I_RELB][rel_bucket(m * dil) * 8 + h]; const float mn = fmaxf(mr, sc), cr = __expf(mr - mn), pe = __expf(sc - mn);
                    lr = lr * cr + pe; o = o * cr + vv * pe; mr = mn; }
            } }
#pragma unroll
        for (int x = 16; x < 64; x <<= 1) { const float m2 = __shfl_xor(mr, x), l2 = __shfl_xor(lr, x); f32x4 o2; o2.x = __shfl_xor(o.x, x); o2.y = __shfl_xor(o.y, x); o2.z = __shfl_xor(o.z, x); o2.w = __shfl_xor(o.w, x);
            const float mn = fmaxf(mr, m2), c1 = __expf(mr - mn), c2 = __expf(m2 - mn); lr = lr * c1 + l2 * c2; o = o * c1 + o2 * c2; mr = mn; }
        if (ks == 0) { const float inv = 1.0f / lr; u32x2 w; w.x = pk2(o.x * inv, o.y * inv); w.y = pk2(o.z * inv, o.w * inv); *(u32x2*)(wsb(p, WS_MIX) + (size_t)row * DM + 512 + h * 64 + 4 * sub) = w; }
    }
}

extern "C" void kernel_launch(void* const* d_in, const int* in_sizes, int n_in, void* d_out, int out_size, void* d_ws, size_t ws_size, hipStream_t stream) {
    static int ok = 0; constexpr int GEMM_LDS = 131072 + 1024;
    if (ok == 0) {
        if (n_in != N_IN || (size_t)out_size != O_END || ws_size < WS_END) { fprintf(stderr, "kernel_launch: unexpected sizes n_in %d out %d ws %zu (want %d %zu %zu)\n", n_in, out_size, ws_size, (int)N_IN, (size_t)O_END, (size_t)WS_END); ok = -1; return; }
        (void)hipFuncSetAttribute((const void*)k_gemm<0>, hipFuncAttributeMaxDynamicSharedMemorySize, GEMM_LDS); (void)hipFuncSetAttribute((const void*)k_gemm<1>, hipFuncAttributeMaxDynamicSharedMemorySize, GEMM_LDS);
        (void)hipFuncSetAttribute((const void*)k_gemm<2>, hipFuncAttributeMaxDynamicSharedMemorySize, GEMM_LDS); (void)hipFuncSetAttribute((const void*)k_gemm<3>, hipFuncAttributeMaxDynamicSharedMemorySize, GEMM_LDS);
        (void)hipFuncSetAttribute((const void*)k_transpose, hipFuncAttributeMaxDynamicSharedMemorySize, 8 * 8704); (void)hipFuncSetAttribute((const void*)k_mod, hipFuncAttributeMaxDynamicSharedMemorySize, 8 * NSEQ * 64 * 4);
        (void)hipFuncSetAttribute((const void*)k_rwkv_prep, hipFuncAttributeMaxDynamicSharedMemorySize, 65536); (void)hipFuncSetAttribute((const void*)k_attn_p, hipFuncAttributeMaxDynamicSharedMemorySize, 3 * 129 * 8 * 4 + 8 * 32 * 144);
        ok = 1;
    }
    if (ok < 0) return;
    P p{}; for (int i = 0; i < N_IN; ++i) p.in[i] = (const float*)d_in[i]; p.out = (float*)d_out; p.ws = (unsigned char*)d_ws; p.layer = 0; p.pad = 0;
    const int G = 256;
    hipLaunchKernelGGL(k_transpose, dim3(G), dim3(NTHR), 8 * 8704, stream, p);
    hipLaunchKernelGGL(k_silu, dim3((NSEQ * DM + 255) / 256), dim3(256), 0, stream, p);
    hipLaunchKernelGGL(k_mod, dim3(NL * 96), dim3(NTHR), 8 * NSEQ * 64 * 4, stream, p);
    hipLaunchKernelGGL(k_norm0, dim3(G), dim3(NTHR), 0, stream, p);
    for (int l = 0; l < NL; ++l) { p.layer = l;
        hipLaunchKernelGGL(k_gemm<0>, dim3(G), dim3(NTHR), GEMM_LDS, stream, p);
        hipLaunchKernelGGL(k_glu, dim3(G), dim3(NTHR), 0, stream, p);
        hipLaunchKernelGGL(k_conv, dim3(2 * G), dim3(NTHR), 0, stream, p);
        hipLaunchKernelGGL(k_rwkv_prep, dim3(2 * G), dim3(NTHR), 65536, stream, p);
        hipLaunchKernelGGL(k_rwkv_scan, dim3(NSEQ * 4), dim3(64), 0, stream, p);
        hipLaunchKernelGGL(k_rwkv_post, dim3(G), dim3(NTHR), 0, stream, p);
        hipLaunchKernelGGL(k_copy_out, dim3(G), dim3(NTHR), 0, stream, p);
        hipLaunchKernelGGL(k_attn_p, dim3(2 * G), dim3(NTHR), 3 * 129 * 8 * 4 + 8 * 32 * 144, stream, p);
        hipLaunchKernelGGL(k_attn_merge, dim3(G), dim3(NTHR), 0, stream, p);
        hipLaunchKernelGGL(k_attn_s, dim3(G / 2), dim3(NTHR), 0, stream, p);
        hipLaunchKernelGGL(k_gemm<1>, dim3(G), dim3(NTHR), GEMM_LDS, stream, p);
        hipLaunchKernelGGL(k_resid, dim3(G), dim3(NTHR), 0, stream, p, 0);
        hipLaunchKernelGGL(k_gemm<2>, dim3(G), dim3(NTHR), GEMM_LDS, stream, p);
        hipLaunchKernelGGL(k_gemm<3>, dim3(G), dim3(NTHR), GEMM_LDS, stream, p);
        hipLaunchKernelGGL(k_resid, dim3(G), dim3(NTHR), 0, stream, p, 1);
    }
}
```

```cpp
#include <hip/hip_runtime.h>
#include <cstdio>
#include <cstdint>

__device__ __forceinline__ int opaque_v(int x) { asm volatile("" : "+v"(x)); return x; }
__device__ __forceinline__ int opaque_s(int x) { asm volatile("" : "+s"(x)); return x; }
#define TIDX opaque_v((int)threadIdx.x)
#define BIDX opaque_s((int)blockIdx.x)
#define GDIM opaque_s((int)gridDim.x)
namespace pg8 {
#define PG8_LAS __attribute__((address_space(3)))
typedef unsigned short bf16_t;
typedef short bf16x8 __attribute__((ext_vector_type(8)));
typedef float f32x4 __attribute__((ext_vector_type(4)));
typedef unsigned u32x4 __attribute__((ext_vector_type(4)));
constexpr int BM = 256, BK = 64, HALF = 128, HTB = HALF * BK * 2  , STAGE_BYTES = 8 * HTB, NXCD = 8, WGM = 8;

__host__ __device__ __forceinline__ int lds_byte(int r, int c) { const int st = (r >> 4) * 2 + (c >> 5), rr = r & 15, cc = c & 31, ob = rr * 64 + cc * 2; return st * 1024 + (ob ^ (((ob >> 9) & 1) << 5)); }
__host__ __device__ __forceinline__ void stage_rc(int b, int& R, int& C) { const int st = b / 1024, sb = b % 1024, swz = sb ^ (((sb >> 9) & 1) << 5); R = (st >> 1) * 16 + swz / 64; C = (st & 1) * 32 + (swz % 64) / 2; }
__host__ __device__ __forceinline__ int perm32(int rho) { const int n = rho >> 4, i = rho & 15; return 8 * (i >> 2) + 4 * n + (i & 3); }

struct Unit { int pm, pn; };
struct Gemm { const bf16_t* A; const bf16_t* Bt; int M, N, K; };

struct StaticOrder {
    int nM, nN, nwg, G, c;
    __host__ __device__ void init(int M, int N, int G_, int c_) { nM = M / BM; nN = N / BM; nwg = nM * nN; G = G_; c = c_; }
    __host__ __device__ bool next(int i, Unit& u) const {
        const long L = (long)i * G + c; if (L >= nwg) return false;
        int wgid = (int)L; { const int q = nwg / NXCD, r = nwg % NXCD, xcd = wgid % NXCD, off = wgid / NXCD; wgid = (xcd < r ? xcd * (q + 1) : r * (q + 1) + (xcd - r) * q) + off; }
        const int nig = WGM * nN, gid = wgid / nig, fm = gid * WGM, gsz = (nM - fm) < WGM ? (nM - fm) : WGM;
        u.pm = fm + ((wgid % nig) % gsz); u.pn = (wgid % nig) / gsz; return true;
    }
    __device__ __forceinline__ void a_ready(const Unit&) const {}
    __device__ __forceinline__ void done(const Unit&) const {}
};

__device__ __forceinline__ unsigned cvt_pk_bf16(float lo, float hi) { unsigned r; asm volatile("v_cvt_pk_bf16_f32 %0, %1, %2" : "=v"(r) : "v"(lo), "v"(hi)); return r; }
typedef float f32x2 __attribute__((ext_vector_type(2)));
struct EpiBf16 {
    static constexpr bool PERM = true, AFTER_DRAIN = false;
    bf16_t* O; int ldc;
    __device__ __forceinline__ void operator()(const f32x4 (&acc)[2][2][4][2], const Unit& u, int wr, int wc, int fr, int fq) const {
        const int row0 = u.pm * BM + wr * 64 + fr; const int col0 = u.pn * BM + wc * 32 + 8 * fq;
#pragma unroll
        for (int ai = 0; ai < 2; ++ai)
#pragma unroll
            for (int m = 0; m < 4; ++m) { bf16_t* rowp = O + (size_t)(row0 + ai * HALF + m * 16) * ldc + col0;
#pragma unroll
                for (int bj = 0; bj < 2; ++bj) { const f32x4 v0 = acc[ai][bj][m][0], v1 = acc[ai][bj][m][1];
                    u32x4 w; w.x = cvt_pk_bf16(v0[0], v0[1]); w.y = cvt_pk_bf16(v0[2], v0[3]); w.z = cvt_pk_bf16(v1[0], v1[1]); w.w = cvt_pk_bf16(v1[2], v1[3]);
                    *(u32x4*)(rowp + bj * HALF) = w; } }
    }
};
struct EpiF32 {
    static constexpr bool PERM = false, AFTER_DRAIN = false;
    float* C; int ldc;
    __device__ __forceinline__ void operator()(const f32x4 (&acc)[2][2][4][2], const Unit& u, int wr, int wc, int fr, int fq) const {
        const int row0 = u.pm * BM + wr * 64 + fr, col0 = u.pn * BM + wc * 32 + 4 * fq;
#pragma unroll
        for (int ai = 0; ai < 2; ++ai)
#pragma unroll
            for (int m = 0; m < 4; ++m) { float* rowp = C + (size_t)(row0 + ai * HALF + m * 16) * ldc + col0;
#pragma unroll
                for (int bj = 0; bj < 2; ++bj)
#pragma unroll
                    for (int n = 0; n < 2; ++n) *(f32x4*)(rowp + bj * HALF + n * 16) = acc[ai][bj][m][n]; }
    }
};
__device__ __forceinline__ float silu_f(float x) { return x / (1.0f + __expf(-x)); }
struct EpiSwiGLU {
    static constexpr bool PERM = true, AFTER_DRAIN = false;
    bf16_t* O; int ldc;
    __device__ __forceinline__ void operator()(const f32x4 (&acc)[2][2][4][2], const Unit& u, int wr, int wc, int fr, int fq) const {
        const int row0 = u.pm * BM + wr * 64 + fr; const int col0 = u.pn * HALF + wc * 32 + 8 * fq;
#pragma unroll
        for (int ai = 0; ai < 2; ++ai)
#pragma unroll
            for (int m = 0; m < 4; ++m) { bf16_t* rowp = O + (size_t)(row0 + ai * HALF + m * 16) * ldc + col0;
                const f32x4 g0 = acc[ai][0][m][0], g1 = acc[ai][0][m][1], u0 = acc[ai][1][m][0], u1 = acc[ai][1][m][1];
                f32x4 v0, v1;
#pragma unroll
                for (int j = 0; j < 4; ++j) { v0[j] = silu_f(g0[j]) * u0[j]; v1[j] = silu_f(g1[j]) * u1[j]; }
                u32x4 w; w.x = cvt_pk_bf16(v0[0], v0[1]); w.y = cvt_pk_bf16(v0[2], v0[3]); w.z = cvt_pk_bf16(v1[0], v1[1]); w.w = cvt_pk_bf16(v1[2], v1[3]);
                *(u32x4*)rowp = w; }
    }
};
template <class Epi, class Sched, bool ALIGN_EPI = false, bool SP2 = false>
__device__ __forceinline__ void gemm_phase(PG8_LAS unsigned char* lds, const Gemm g, const Sched& S, const Epi& E) {
    const int tid = TIDX, wid = __builtin_amdgcn_readfirstlane(tid >> 6), lane = tid & 63, wr = wid >> 2, wc = wid & 3, fr = lane & 15, fq = lane >> 4;
    const int K = g.K, nt = K / BK;
    unsigned voffA[2], voffB[2];
#pragma unroll
    for (int i = 0; i < 2; ++i) { int R, C; stage_rc(tid * 16 + i * 8192, R, C); const int Rb = Epi::PERM ? ((R & ~31) + perm32(R & 31)) : R;
        voffA[i] = (unsigned)(R * K + C) * 2u; voffB[i] = (unsigned)(Rb * K + C) * 2u; }
    const size_t kstep = (size_t)(BK * 2);
    const size_t hstep = (size_t)HALF * K * 2;
    const size_t tstep = 2 * hstep;
    const unsigned ldsw = (unsigned)wid * 1024u;
    const int aoff = lds_byte(wr * 64 + fr, fq * 8), boff = lds_byte(wc * 32 + fr, fq * 8);
#define PG8_SA(b, h) (((b) * 2 + (h)) * HTB)
#define PG8_SB(b, h) ((4 + (b) * 2 + (h)) * HTB)
#define PG8_STAGE(bufoff, gbase, voff) do { _Pragma("unroll") for (int _i = 0; _i < 2; ++_i) \
        __builtin_amdgcn_global_load_lds((const unsigned*)((const char*)(gbase) + (voff)[_i]), (PG8_LAS unsigned*)(lds + (bufoff) + ldsw + _i * 8192), 16, 0, 0); } while (0)
#define PG8_LDA(dst, b, h) do { _Pragma("unroll") for (int m = 0; m < 4; ++m) _Pragma("unroll") for (int k = 0; k < 2; ++k) dst[m][k] = *(const PG8_LAS bf16x8*)(lds + PG8_SA(b, h) + aoff + m * 2048 + k * 1024); } while (0)
#define PG8_LDB(dst, b, h) do { _Pragma("unroll") for (int n = 0; n < 2; ++n) _Pragma("unroll") for (int k = 0; k < 2; ++k) dst[n][k] = *(const PG8_LAS bf16x8*)(lds + PG8_SB(b, h) + boff + n * 2048 + k * 1024); } while (0)
#define PG8_MMA(ai, bj, At, Bt) do { __builtin_amdgcn_s_setprio(1); _Pragma("unroll") for (int m = 0; m < 4; ++m) _Pragma("unroll") for (int n = 0; n < 2; ++n) _Pragma("unroll") for (int k = 0; k < 2; ++k) \
        acc[ai][bj][m][n] = __builtin_amdgcn_mfma_f32_16x16x32_bf16(Bt[n][k], At[m][k], acc[ai][bj][m][n], 0, 0, 0); __builtin_amdgcn_s_setprio(0); } while (0)
#define PG8_WAIT_V(n) asm volatile("s_waitcnt vmcnt(" #n ")" ::: "memory")
#define PG8_WAIT_L(n) asm volatile("s_waitcnt lgkmcnt(" #n ")" ::: "memory")
#define PG8_BAR __builtin_amdgcn_s_barrier()
#define PG8_SCHED __builtin_amdgcn_sched_barrier(0)
    Unit cur, nxt; int ui = 0;
    if (!S.next(0, cur)) return;
    f32x4 acc[2][2][4][2];
#pragma unroll
    for (int a = 0; a < 2; ++a)
#pragma unroll
        for (int b = 0; b < 2; ++b)
#pragma unroll
            for (int m = 0; m < 4; ++m)
#pragma unroll
                for (int n = 0; n < 2; ++n) acc[a][b][m][n] = (f32x4){0.f, 0.f, 0.f, 0.f};
    bf16x8 At[4][2], B0[2][2], B1[2][2];
    const char* cA = (const char*)g.A + (size_t)cur.pm * tstep; const char* cB = (const char*)g.Bt + (size_t)cur.pn * tstep;
    S.a_ready(cur);
    if constexpr (SP2) {
        PG8_STAGE(PG8_SB(0, 0), cB, voffB); PG8_STAGE(PG8_SB(0, 1), cB + hstep, voffB); PG8_STAGE(PG8_SA(0, 0), cA, voffA); PG8_STAGE(PG8_SA(0, 1), cA + hstep, voffA);
        if (wr == 1) PG8_BAR;
        PG8_WAIT_V(2); PG8_BAR;
        PG8_STAGE(PG8_SB(1, 0), cB + kstep, voffB); PG8_STAGE(PG8_SA(1, 0), cA + kstep, voffA); PG8_STAGE(PG8_SB(1, 1), cB + hstep + kstep, voffB);
        PG8_WAIT_V(6); PG8_BAR;
    } else {
        PG8_STAGE(PG8_SB(0, 0), cB, voffB); PG8_STAGE(PG8_SA(0, 0), cA, voffA); PG8_STAGE(PG8_SB(0, 1), cB + hstep, voffB); PG8_STAGE(PG8_SA(0, 1), cA + hstep, voffA);
        if (wr == 1) PG8_BAR;
        PG8_WAIT_V(4); PG8_BAR;
        PG8_STAGE(PG8_SB(1, 0), cB + kstep, voffB); PG8_STAGE(PG8_SA(1, 0), cA + kstep, voffA); PG8_STAGE(PG8_SB(1, 1), cB + hstep + kstep, voffB);
        PG8_WAIT_V(6); PG8_BAR;
    }
    for (;;) {
        const bool has_next = S.next(ui + 1, nxt);
        const char* nA = has_next ? (const char*)g.A + (size_t)nxt.pm * tstep : cA; const char* nB = has_next ? (const char*)g.Bt + (size_t)nxt.pn * tstep : cB;
        for (int t = 0; t < nt; t += 2) {
            const bool last = (t == nt - 2);
            const char* a1 = cA + (size_t)(t + 1) * kstep;
            const char* a2 = last ? nA : cA + (size_t)(t + 2) * kstep; const char* b2 = last ? nB : cB + (size_t)(t + 2) * kstep;
            const char* a3 = a2 + kstep; const char* b3 = b2 + kstep;
            if (last && has_next) S.a_ready(nxt);
            if constexpr (SP2) {
            PG8_LDB(B0, 0, 0); PG8_LDB(B1, 0, 1); PG8_SCHED; PG8_LDA(At, 0, 0); PG8_STAGE(PG8_SA(1, 1), a1 + hstep, voffA);
            PG8_WAIT_V(8); PG8_WAIT_L(0); PG8_BAR; PG8_MMA(0, 0, At, B0); PG8_MMA(0, 1, At, B1); PG8_BAR; PG8_SCHED;
            PG8_LDA(At, 0, 1); PG8_STAGE(PG8_SB(0, 0), b2, voffB); PG8_STAGE(PG8_SB(0, 1), b2 + hstep, voffB); PG8_STAGE(PG8_SA(0, 0), a2, voffA);
            PG8_WAIT_V(8); PG8_WAIT_L(0); PG8_BAR; PG8_MMA(1, 0, At, B0); PG8_MMA(1, 1, At, B1); PG8_BAR; PG8_SCHED;
            PG8_LDB(B0, 1, 0); PG8_LDB(B1, 1, 1); PG8_SCHED; PG8_LDA(At, 1, 0); PG8_STAGE(PG8_SA(0, 1), a2 + hstep, voffA);
            PG8_WAIT_V(8); PG8_WAIT_L(0); PG8_BAR; PG8_MMA(0, 0, At, B0); PG8_MMA(0, 1, At, B1); PG8_BAR; PG8_SCHED;
            PG8_LDA(At, 1, 1); PG8_STAGE(PG8_SB(1, 0), b3, voffB); PG8_STAGE(PG8_SB(1, 1), b3 + hstep, voffB); PG8_STAGE(PG8_SA(1, 0), a3, voffA);
            PG8_WAIT_V(8); PG8_WAIT_L(0); PG8_BAR; PG8_MMA(1, 0, At, B0); PG8_MMA(1, 1, At, B1); PG8_BAR; PG8_SCHED;
            } else {
            PG8_LDB(B0, 0, 0); PG8_SCHED; PG8_LDA(At, 0, 0); PG8_STAGE(PG8_SA(1, 1), a1 + hstep, voffA);
            PG8_WAIT_L(8); PG8_BAR; PG8_WAIT_L(0); PG8_MMA(0, 0, At, B0); PG8_BAR; PG8_SCHED;
            PG8_LDB(B1, 0, 1); PG8_STAGE(PG8_SB(0, 0), b2, voffB);
            PG8_BAR; PG8_WAIT_L(0); PG8_MMA(0, 1, At, B1); PG8_BAR;
            PG8_LDA(At, 0, 1); PG8_STAGE(PG8_SA(0, 0), a2, voffA);
            PG8_BAR; PG8_WAIT_L(0); PG8_MMA(1, 0, At, B0); PG8_BAR; PG8_SCHED;
            PG8_STAGE(PG8_SB(0, 1), b2 + hstep, voffB);
            PG8_WAIT_V(6); PG8_BAR; PG8_MMA(1, 1, At, B1); PG8_BAR;
            PG8_LDB(B0, 1, 0); PG8_SCHED; PG8_LDA(At, 1, 0); PG8_STAGE(PG8_SA(0, 1), a2 + hstep, voffA);
            PG8_WAIT_L(8); PG8_BAR; PG8_WAIT_L(0); PG8_MMA(0, 0, At, B0); PG8_BAR; PG8_SCHED;
            PG8_LDB(B1, 1, 1); PG8_STAGE(PG8_SB(1, 0), b3, voffB);
            PG8_BAR; PG8_WAIT_L(0); PG8_MMA(0, 1, At, B1); PG8_BAR;
            PG8_LDA(At, 1, 1); PG8_STAGE(PG8_SA(1, 0), a3, voffA);
            PG8_BAR; PG8_WAIT_L(0); PG8_MMA(1, 0, At, B0); PG8_BAR; PG8_SCHED;
            PG8_STAGE(PG8_SB(1, 1), b3 + hstep, voffB);
            PG8_WAIT_V(6); PG8_BAR; PG8_MMA(1, 1, At, B1); PG8_BAR;
            }
        }
        if constexpr (ALIGN_EPI) { if (wr == 0) PG8_BAR; }
        if constexpr (!Epi::AFTER_DRAIN) { E(acc, cur, wr, wc, fr, fq); S.done(cur); }
        if (!has_next) break;
#pragma unroll
        for (int a = 0; a < 2; ++a)
#pragma unroll
            for (int b = 0; b < 2; ++b)
#pragma unroll
                for (int m = 0; m < 4; ++m)
#pragma unroll
                    for (int n = 0; n < 2; ++n) acc[a][b][m][n] = (f32x4){0.f, 0.f, 0.f, 0.f};
        cur = nxt; cA = nA; cB = nB; ++ui;
        if constexpr (ALIGN_EPI) { if (wr == 1) PG8_BAR; }
    }
    PG8_WAIT_V(0);
    if constexpr (!ALIGN_EPI) { if (wr == 0) PG8_BAR; }
    PG8_BAR;
    if constexpr (Epi::AFTER_DRAIN) { E.fused(acc, cur, wr, wc, fr, fq, lds, wid, lane); S.done(cur); }
#undef PG8_SA
#undef PG8_SB
#undef PG8_STAGE
#undef PG8_LDA
#undef PG8_LDB
#undef PG8_MMA
#undef PG8_WAIT_V
#undef PG8_WAIT_L
#undef PG8_BAR
#undef PG8_SCHED
}
}

constexpr int DM = 1024, NBP = 4, TP = 4096, NL = 4, NBS = 32, TS = 4;
constexpr int MP = NBP * TP, MS = NBS * TS, MR = MP + MS, MPAD = 16640, NSEQ = NBP + NBS;
constexpr int INC = 3072, FF = 2816, FF2 = 5632, CKW = 31, WINB = 2048;
constexpr int UC_CA = 0, UC_CG = 256, UC_R = 512, UC_AQ = 1536, UC_AK = 2048, UC_AV = 2560;
constexpr int NTHR = 512, NWAVES = 8;
constexpr size_t O_YP = 0, O_YS = O_YP + (size_t)MP * DM, O_CONVP = O_YS + (size_t)MS * DM, O_CONVS = O_CONVP + (size_t)NL * NBP * 30 * 256,
    O_SHP = O_CONVS + (size_t)NL * NBS * 30 * 256, O_SHS = O_SHP + (size_t)NL * NBP * 1024, O_WKVP = O_SHS + (size_t)NL * NBS * 1024,
    O_WKVS = O_WKVP + (size_t)NL * NBP * 4 * 4096, O_KP = O_WKVS + (size_t)NL * NBS * 4 * 4096, O_KS = O_KP + (size_t)NL * NBP * WINB * 512,
    O_VP = O_KS + (size_t)NL * NBS * TS * 512, O_VS = O_VP + (size_t)NL * NBP * WINB * 512, O_END = O_VS + (size_t)NL * NBS * TS * 512;
enum { I_XP = 0, I_XS, I_CP, I_CS, I_CCONV, I_SSHIFT, I_SWKV, I_CK, I_CV, I_WADA, I_BADA, I_GPM, I_GPOM, I_GPF, I_GPOF, I_WIN, I_WOUT, I_CONVW, I_CONVB, I_CLNG, I_CLNB,
       I_MU, I_W0, I_W2, I_A0, I_A2, I_G2, I_KK, I_KA, I_RK, I_LNG, I_LNB, I_RELB, I_WF1, I_WF2, N_IN };
constexpr size_t MiB = 1u << 20;
constexpr size_t WS_CTL = 0, WS_WIN = 1 * MiB, WS_WOUT = WS_WIN + 24 * MiB, WS_WF1 = WS_WOUT + 8 * MiB, WS_WF2 = WS_WF1 + 44 * MiB, WS_MOD = WS_WF2 + 22 * MiB,
    WS_SC = WS_MOD + 4 * MiB, WS_XN = WS_SC + 1 * MiB, WS_U = WS_XN + 34 * MiB, WS_MIX = WS_U + 98 * MiB, WS_T = WS_MIX + 34 * MiB, WS_H = WS_T + 66 * MiB,
    WS_Z = WS_H + 90 * MiB, WS_STR = WS_Z + 17 * MiB  , WS_YR = WS_STR + 7 * 17 * MiB, WS_OP = WS_YR + 17 * MiB  , WS_ML = WS_OP + 96 * MiB, WS_END = WS_ML + 4 * MiB;
constexpr size_t STR_STRIDE = 17 * MiB / 4;
enum { S_W = 0, S_KK, S_KA, S_KP, S_R, S_V, S_G };

typedef unsigned short bf16;
typedef float f32x4 __attribute__((ext_vector_type(4)));
typedef short bf16x8 __attribute__((ext_vector_type(8)));
typedef short s16x4 __attribute__((ext_vector_type(4)));
typedef unsigned u32x4 __attribute__((ext_vector_type(4)));
typedef unsigned u32x2 __attribute__((ext_vector_type(2)));
#define LAS __attribute__((address_space(3)))
__device__ __forceinline__ float bf2f(unsigned b) { return __uint_as_float(b << 16); }
__device__ __forceinline__ unsigned f2bf(float f) { unsigned u = __float_as_uint(f); return (u + 0x7fffu + ((u >> 16) & 1u)) >> 16; }
__device__ __forceinline__ unsigned pk2(float lo, float hi) { return f2bf(lo) | (f2bf(hi) << 16); }
__device__ __forceinline__ float sigmoid_f(float x) { return 1.0f / (1.0f + __expf(-x)); }
__device__ __forceinline__ float wave_sum(float v) {
#pragma unroll
    for (int o = 1; o < 64; o <<= 1) v += __shfl_xor(v, o);
    return v;
}

#define XB_TMO      128
#define XB_XCNT(j)  (256  + 64 * (j))
#define XB_XSUB(j)  (1280 + 64 * (j))
#define XB_XGEN(j)  (2304 + 64 * (j))
#define XB_TOP      3328
#define XB_TOPGEN   3392
#define XCD_BAR_WORDS 3456
#define XB_SPIN_CAP (1u << 18)

__device__ __forceinline__ unsigned xb_ld(unsigned* p)              { return __hip_atomic_load(p, __ATOMIC_RELAXED, __HIP_MEMORY_SCOPE_AGENT); }
__device__ __forceinline__ unsigned xb_add(unsigned* p, unsigned v) { return __hip_atomic_fetch_add(p, v, __ATOMIC_RELAXED, __HIP_MEMORY_SCOPE_AGENT); }
__device__ __forceinline__ unsigned xb_xcc_id() { return (unsigned)__builtin_amdgcn_s_getreg((3 << 11) | 20) & 0xFu; }
#define XB_SPIN(cond, bar) do { unsigned _sp = 0; while (cond) { __builtin_amdgcn_s_sleep(1); \
    if ((++_sp & 255u) == 0u) { if (xb_ld(&(bar)[XB_TMO])) break; if (_sp > XB_SPIN_CAP) { atomicAdd(&(bar)[XB_TMO], 1u); break; } } } } while (0)

struct XcdBarrier {
    unsigned* bar; unsigned x;
    volatile LAS unsigned* st;
};

__device__ __forceinline__ XcdBarrier xcd_barrier_post(unsigned* bar, volatile LAS unsigned* st) {
    XcdBarrier b; b.bar = bar; b.x = xb_xcc_id(); b.st = st;
    if (threadIdx.x == 0) (void)xb_add(&bar[XB_XCNT(b.x)], 1u);
    return b;
}
__device__ __forceinline__ void xcd_barrier_complete(unsigned* bar, unsigned x, unsigned& nloc, unsigned& nx) {
    const unsigned G = gridDim.x * gridDim.y * gridDim.z;
    unsigned sum, cnt, mine, sp = 0u;
    for (;;) {
        sum = 0u; cnt = 0u; mine = 0u;
#pragma unroll
        for (unsigned j = 0; j < 16; ++j) { const unsigned c = xb_ld(&bar[XB_XCNT(j)]); sum += c; cnt += (c > 0u) ? 1u : 0u; mine = (j == x) ? c : mine; }
        if (sum == G) break;
        __builtin_amdgcn_s_sleep(1);
        if ((++sp & 255u) == 0u) { if (xb_ld(&bar[XB_TMO])) break; if (sp > XB_SPIN_CAP) { atomicAdd(&bar[XB_TMO], 1u); break; } }
    }
    nloc = mine > 0u ? mine : 1u; nx = cnt > 0u ? cnt : 1u;
}

__device__ __forceinline__ void xcd_barrier(const XcdBarrier& b) {
    asm volatile("s_waitcnt vmcnt(0)" ::: "memory");
    __syncthreads();
    if (threadIdx.x == 0) {
        unsigned* bar = b.bar;
        __builtin_amdgcn_s_waitcnt(0);
        unsigned nloc = b.st[0], nx = b.st[1];
        if (nloc == 0u) { xcd_barrier_complete(bar, b.x, nloc, nx); b.st[0] = nloc; b.st[1] = nx; }
        const unsigned old = xb_add(&bar[XB_XSUB(b.x)], 1u);
        const unsigned gen = old / nloc;
        if (old + 1u == (gen + 1u) * nloc) {
            __builtin_amdgcn_fence(__ATOMIC_RELEASE, "agent");
            asm volatile("s_waitcnt vmcnt(0)" ::: "memory");
            const unsigned og = xb_add(&bar[XB_TOP], 1u);
            const unsigned tg = og / nx;
            if (og + 1u == (tg + 1u) * nx) xb_add(&bar[XB_TOPGEN], 1u);
            else XB_SPIN(xb_ld(&bar[XB_TOPGEN]) == tg, bar);
            __builtin_amdgcn_fence(__ATOMIC_ACQUIRE, "agent");
            xb_add(&bar[XB_XGEN(b.x)], 1u);
            asm volatile("s_waitcnt vmcnt(0)" ::: "memory");
        } else {
            XB_SPIN(xb_ld(&bar[XB_XGEN(b.x)]) == gen, bar);
            __builtin_amdgcn_fence(__ATOMIC_ACQUIRE, "agent");
            asm volatile("s_waitcnt vmcnt(0)" ::: "memory");
        }
    }
    __syncthreads();
}

struct P {
    const float* in[N_IN]; float* out; unsigned char* ws;
};
__device__ __forceinline__ bf16* wsb(const P& p, size_t off) { return (bf16*)(p.ws + off); }
__device__ __forceinline__ float* wsf(const P& p, size_t off) { return (float*)(p.ws + off); }
__device__ __forceinline__ const float* modv(const P& p, int l, int s, int j) { return wsf(p, WS_MOD) + ((size_t)(l * NSEQ + s) * 6 + j) * DM; }
__device__ __forceinline__ int seq_of_row(int row) { return row < MP ? (row >> 12) : NBP + ((row - MP) >> 2); }

__device__ __forceinline__ void transpose_item(const float* W, int K, int N, bf16* WT, int drow0, LAS float* scr, int k0, int n0, int lane) {
#pragma unroll 8
    for (int i = 0; i < 32; ++i) { const int kk = 2 * i + (lane >> 5); scr[kk * 33 + (lane & 31)] = W[(size_t)(k0 + kk) * N + n0 + (lane & 31)]; }
    asm volatile("s_waitcnt lgkmcnt(0)" ::: "memory");
    const int c = lane & 7;
#pragma unroll
    for (int j = 0; j < 4; ++j) { const int n = (lane >> 3) + 8 * j; const LAS float* s = scr + (8 * c) * 33 + n;
        u32x4 o; o.x = pk2(s[0 * 33], s[1 * 33]); o.y = pk2(s[2 * 33], s[3 * 33]); o.z = pk2(s[4 * 33], s[5 * 33]); o.w = pk2(s[6 * 33], s[7 * 33]);
        *(u32x4*)(WT + (size_t)(drow0 + n) * K + k0 + 8 * c) = o; }
    asm volatile("s_waitcnt lgkmcnt(0)" ::: "memory");
}
__device__ __forceinline__ void ph_transpose(const P& p, LAS unsigned char* lds) {
    const int tid = TIDX, lane = tid & 63, wave = tid >> 6;
    LAS float* scr = (LAS float*)(lds + wave * 8704);
    const int gw = BIDX * NWAVES + wave, NGW = GDIM * NWAVES;
    constexpr int I_A = 16 * (INC / 32), I_B = 16 * (DM / 32), I_C = 16 * (FF2 / 32), I_D = (FF / 64) * (DM / 32), I_L = I_A + I_B + I_C + I_D;
    for (int it = gw; it < NL * I_L; it += NGW) {
        const int l = it / I_L; int r = it % I_L;
        if (r < I_A) { const int nb = INC / 32, kb = r / nb, n0 = 32 * (r % nb); transpose_item(p.in[I_WIN] + (size_t)l * DM * INC, DM, INC, wsb(p, WS_WIN) + (size_t)l * INC * DM, n0, scr, 64 * kb, n0, lane); continue; } r -= I_A;
        if (r < I_B) { const int nb = DM / 32, kb = r / nb, n0 = 32 * (r % nb); transpose_item(p.in[I_WOUT] + (size_t)l * DM * DM, DM, DM, wsb(p, WS_WOUT) + (size_t)l * DM * DM, n0, scr, 64 * kb, n0, lane); continue; } r -= I_B;
        if (r < I_C) { const int nb = FF2 / 32, kb = r / nb, n0 = 32 * (r % nb);
            const int f = n0 < FF ? n0 : n0 - FF; const int drow0 = (f / 128) * 256 + (n0 < FF ? 0 : 128) + (f % 128);
            transpose_item(p.in[I_WF1] + (size_t)l * DM * FF2, DM, FF2, wsb(p, WS_WF1) + (size_t)l * FF2 * DM, drow0, scr, 64 * kb, n0, lane); continue; } r -= I_C;
        { const int nb = DM / 32, kb = r / nb, n0 = 32 * (r % nb); transpose_item(p.in[I_WF2] + (size_t)l * FF * DM, FF, DM, wsb(p, WS_WF2) + (size_t)l * DM * FF, n0, scr, 64 * kb, n0, lane); }
    }
}
__device__ __forceinline__ void ph_silu(const P& p) {
    for (int i = BIDX * NTHR + TIDX; i < NSEQ * DM; i += GDIM * NTHR) { const int s = i / DM, k = i % DM; const float c = s < NBP ? p.in[I_CP][s * DM + k] : p.in[I_CS][(s - NBP) * DM + k]; wsf(p, WS_SC)[i] = c * sigmoid_f(c); }
}
__device__ __forceinline__ void ph_mod(const P& p, LAS unsigned char* lds) {
    LAS float* red = (LAS float*)lds;
    const int tid = TIDX, lane = tid & 63, wave = tid >> 6;
    const float* SC = wsf(p, WS_SC);
    for (int it = BIDX; it < NL * 96; it += GDIM) {
        const int l = it / 96, col = (it % 96) * 64 + lane;
        float acc[NSEQ];
#pragma unroll
        for (int s = 0; s < NSEQ; ++s) acc[s] = 0.f;
        const float* W = p.in[I_WADA] + (size_t)l * DM * 6144 + col;
        for (int k = wave * 128; k < wave * 128 + 128; ++k) { const float w = W[(size_t)k * 6144];
#pragma unroll
            for (int s = 0; s < NSEQ; ++s) acc[s] += SC[s * DM + k] * w; }
#pragma unroll
        for (int s = 0; s < NSEQ; ++s) red[(wave * NSEQ + s) * 64 + lane] = acc[s];
        __syncthreads();
        for (int e = tid; e < NSEQ * 64; e += NTHR) { const int s = e >> 6, c = e & 63; float v = 0.f;
#pragma unroll
            for (int w = 0; w < 8; ++w) v += red[(w * NSEQ + s) * 64 + c];
            const int cc = (it % 96) * 64 + c; wsf(p, WS_MOD)[(size_t)(l * NSEQ + s) * 6144 + cc] = v + p.in[I_BADA][l * 6144 + cc]; }
        __syncthreads();
    }
}
__device__ __forceinline__ void norm_row_bf16(const float* xrow, const float* g, const float* scale, const float* shift, bf16* orow, int lane) {
    const f32x4* xr = (const f32x4*)xrow + lane; f32x4 v[4]; float s = 0.f;
#pragma unroll
    for (int j = 0; j < 4; ++j) { v[j] = xr[64 * j]; s += (v[j].x * v[j].x + v[j].y * v[j].y) + (v[j].z * v[j].z + v[j].w * v[j].w); }
    const float rstd = 1.0f / sqrtf(wave_sum(s) * (1.0f / DM) + 1e-6f);
#pragma unroll
    for (int j = 0; j < 4; ++j) { const int c = 4 * lane + 256 * j; const f32x4 gg = *(const f32x4*)(g + c), sc = *(const f32x4*)(scale + c), sh = *(const f32x4*)(shift + c);
        f32x4 o; o.x = v[j].x * rstd * gg.x * (1.f + sc.x) + sh.x; o.y = v[j].y * rstd * gg.y * (1.f + sc.y) + sh.y; o.z = v[j].z * rstd * gg.z * (1.f + sc.z) + sh.z; o.w = v[j].w * rstd * gg.w * (1.f + sc.w) + sh.w;
        u32x2 w; w.x = pk2(o.x, o.y); w.y = pk2(o.z, o.w); *(u32x2*)(orow + c) = w; }
}
__device__ __forceinline__ void ph_norm0(const P& p) {
    const int lane = TIDX & 63, gw = BIDX * NWAVES + (TIDX >> 6), NGW = GDIM * NWAVES;
    for (int row = gw; row < MR; row += NGW) { const int s = seq_of_row(row);
        const float* x = row < MP ? p.in[I_XP] + (size_t)row * DM : p.in[I_XS] + (size_t)(row - MP) * DM;
        norm_row_bf16(x, p.in[I_GPM], modv(p, 0, s, 1), modv(p, 0, s, 0), wsb(p, WS_XN) + (size_t)row * DM, lane); }
}
__device__ __forceinline__ void ph_resid(const P& p, int l, const int which) {
    const int lane = TIDX & 63, gw = BIDX * NWAVES + (TIDX >> 6), NGW = GDIM * NWAVES;
    for (int row = gw; row < MR; row += NGW) { const int s = seq_of_row(row);
        const float* xin = (l == 0 && which == 0) ? (row < MP ? p.in[I_XP] + (size_t)row * DM : p.in[I_XS] + (size_t)(row - MP) * DM) : p.out + (size_t)row * DM;
        float* xout = p.out + (size_t)row * DM;
        const float* t = wsf(p, WS_T) + (size_t)row * DM;
        const float* gpost = p.in[which == 0 ? I_GPOM : I_GPOF] + l * DM; const float* gate = modv(p, l, s, which == 0 ? 2 : 5);
        f32x4 tv[4], xv[4]; float ss = 0.f;
#pragma unroll
        for (int j = 0; j < 4; ++j) { tv[j] = ((const f32x4*)t)[lane + 64 * j]; xv[j] = ((const f32x4*)xin)[lane + 64 * j]; ss += (tv[j].x * tv[j].x + tv[j].y * tv[j].y) + (tv[j].z * tv[j].z + tv[j].w * tv[j].w); }
        const float rstd = 1.0f / sqrtf(wave_sum(ss) * (1.0f / DM) + 1e-6f); float s2 = 0.f;
#pragma unroll
        for (int j = 0; j < 4; ++j) { const int c = 4 * lane + 256 * j; const f32x4 gp = *(const f32x4*)(gpost + c), ga = *(const f32x4*)(gate + c);
            xv[j].x += ga.x * (tv[j].x * rstd * gp.x); xv[j].y += ga.y * (tv[j].y * rstd * gp.y); xv[j].z += ga.z * (tv[j].z * rstd * gp.z); xv[j].w += ga.w * (tv[j].w * rstd * gp.w);
            ((f32x4*)xout)[lane + 64 * j] = xv[j]; s2 += (xv[j].x * xv[j].x + xv[j].y * xv[j].y) + (xv[j].z * xv[j].z + xv[j].w * xv[j].w); }
        if (which == 1 && l == NL - 1) continue;
        const int ln = which == 0 ? l : l + 1;
        const float* gn = p.in[which == 0 ? I_GPF : I_GPM] + ln * DM; const float* sc = modv(p, ln, s, which == 0 ? 4 : 1); const float* sh = modv(p, ln, s, which == 0 ? 3 : 0);
        const float rstd2 = 1.0f / sqrtf(wave_sum(s2) * (1.0f / DM) + 1e-6f); bf16* orow = wsb(p, WS_XN) + (size_t)row * DM;
#pragma unroll
        for (int j = 0; j < 4; ++j) { const int c = 4 * lane + 256 * j; const f32x4 gg = *(const f32x4*)(gn + c), s_ = *(const f32x4*)(sc + c), h_ = *(const f32x4*)(sh + c);
            u32x2 w; w.x = pk2(xv[j].x * rstd2 * gg.x * (1.f + s_.x) + h_.x, xv[j].y * rstd2 * gg.y * (1.f + s_.y) + h_.y); w.y = pk2(xv[j].z * rstd2 * gg.z * (1.f + s_.z) + h_.z, xv[j].w * rstd2 * gg.w * (1.f + s_.w) + h_.w);
            *(u32x2*)(orow + c) = w; }
    }
}

template <int WHICH> __device__ __forceinline__ void ph_gemm(const P& p, int l, LAS unsigned char* lds) {
    pg8::StaticOrder S;
    if constexpr (WHICH == 0) { pg8::Gemm g{wsb(p, WS_XN), wsb(p, WS_WIN) + (size_t)l * INC * DM, MPAD, INC, DM}; S.init(MPAD, INC, GDIM, BIDX);
        pg8::EpiBf16 E{wsb(p, WS_U), INC}; pg8::gemm_phase<pg8::EpiBf16, pg8::StaticOrder, true, true>(lds, g, S, E); }
    if constexpr (WHICH == 1) { pg8::Gemm g{wsb(p, WS_MIX), wsb(p, WS_WOUT) + (size_t)l * DM * DM, MPAD, DM, DM}; S.init(MPAD, DM, GDIM, BIDX);
        pg8::EpiF32 E{wsf(p, WS_T), DM}; pg8::gemm_phase<pg8::EpiF32, pg8::StaticOrder, true, true>(lds, g, S, E); }
    if constexpr (WHICH == 2) { pg8::Gemm g{wsb(p, WS_XN), wsb(p, WS_WF1) + (size_t)l * FF2 * DM, MPAD, FF2, DM}; S.init(MPAD, FF2, GDIM, BIDX);
        pg8::EpiSwiGLU E{wsb(p, WS_H), FF}; pg8::gemm_phase<pg8::EpiSwiGLU, pg8::StaticOrder, true, true>(lds, g, S, E); }
    if constexpr (WHICH == 3) { pg8::Gemm g{wsb(p, WS_H), wsb(p, WS_WF2) + (size_t)l * DM * FF, MPAD, DM, FF}; S.init(MPAD, DM, GDIM, BIDX);
        pg8::EpiF32 E{wsf(p, WS_T), DM}; pg8::gemm_phase<pg8::EpiF32, pg8::StaticOrder, true, true>(lds, g, S, E); }
}

__device__ __forceinline__ void ph_glu(const P& p, int l) {
    const bf16* U = wsb(p, WS_U); float* Z = wsf(p, WS_Z);
    const int gt = BIDX * NTHR + TIDX, NT = GDIM * NTHR;
    for (int idx = gt; idx < MR * 64; idx += NT) { const int row = idx >> 6, c4 = (idx & 63) * 4;
        const u32x2 a = *(const u32x2*)(U + (size_t)row * INC + UC_CA + c4), g = *(const u32x2*)(U + (size_t)row * INC + UC_CG + c4);
        f32x4 z; z.x = bf2f(a.x & 0xffffu) * sigmoid_f(bf2f(g.x & 0xffffu)); z.y = bf2f(a.x >> 16) * sigmoid_f(bf2f(g.x >> 16)); z.z = bf2f(a.y & 0xffffu) * sigmoid_f(bf2f(g.y & 0xffffu)); z.w = bf2f(a.y >> 16) * sigmoid_f(bf2f(g.y >> 16));
        *(f32x4*)(Z + (size_t)row * 256 + c4) = z;
        if (row < MP) { const int n = row >> 12, t = row & 4095; if (t >= TP - 30) *(f32x4*)(p.out + O_CONVP + ((size_t)(l * NBP + n) * 30 + (t - (TP - 30))) * 256 + c4) = z; }
        else { const int rs = row - MP, n = rs >> 2, s = rs & 3; *(f32x4*)(p.out + O_CONVS + ((size_t)(l * NBS + n) * 30 + 26 + s) * 256 + c4) = z; }
    }
    for (int idx = gt; idx < NBS * 26 * 64; idx += NT) { const int n = idx / (26 * 64), r = idx % (26 * 64), i = r >> 6, c4 = (r & 63) * 4;
        *(f32x4*)(p.out + O_CONVS + ((size_t)(l * NBS + n) * 30 + i) * 256 + c4) = *(const f32x4*)(p.in[I_CCONV] + ((size_t)(l * NBS + n) * 30 + i + 4) * 256 + c4); }
}
__device__ __forceinline__ void ph_conv(const P& p, int l, LAS unsigned char* lds, const int b0, const int nb) {
    LAS float (*red)[2][4] = (LAS float (*)[2][4])lds;
    const int tid = TIDX, c = tid & 255, half = tid >> 8, wv = (tid >> 6) & 3, lane = tid & 63;
    const float* Z = wsf(p, WS_Z); const float* cw = p.in[I_CONVW] + (size_t)l * CKW * 256 + c;
    float w[CKW];
#pragma unroll
    for (int j = 0; j < CKW; ++j) w[j] = cw[j * 256];
    const float cb = p.in[I_CONVB][l * 256 + c], lg = p.in[I_CLNG][l * 256 + c], lb = p.in[I_CLNB][l * 256 + c];
    for (int pr = b0; pr < MR / 2; pr += nb) { const int row = 2 * pr + half; float acc = cb;
        if (row < MP) { const int t = row & 4095;
#pragma unroll
            for (int j = 0; j < CKW; ++j) { const int tau = t + j - 30; if (tau >= 0) acc += w[j] * Z[(size_t)(row + j - 30) * 256 + c]; } }
        else { const int rs = row - MP, n = rs >> 2, s = rs & 3;
#pragma unroll
            for (int j = 0; j < CKW; ++j) { const int tau = s + j - 30; const float z = tau >= 0 ? Z[(size_t)(MP + n * 4 + tau) * 256 + c] : p.in[I_CCONV][((size_t)(l * NBS + n) * 30 + 30 + tau) * 256 + c]; acc += w[j] * z; } }
        float s1 = wave_sum(acc); if (lane == 0) red[0][half][wv] = s1; __syncthreads();
        const float mean = (red[0][half][0] + red[0][half][1] + red[0][half][2] + red[0][half][3]) * (1.f / 256.f); const float d = acc - mean;
        float s2 = wave_sum(d * d); if (lane == 0) red[1][half][wv] = s2; __syncthreads();
        const float var = (red[1][half][0] + red[1][half][1] + red[1][half][2] + red[1][half][3]) * (1.f / 256.f);
        const float y = d * (1.0f / sqrtf(var + 1e-5f)) * lg + lb;
        wsb(p, WS_MIX)[(size_t)row * DM + c] = (bf16)f2bf(y * sigmoid_f(y));
        __syncthreads();
    }
}
__device__ __forceinline__ void ph_rwkv_prep(const P& p, int l, LAS unsigned char* lds) {
    LAS float* xs = (LAS float*)lds;
    const int tid = TIDX, c = tid & 255, half = tid >> 8;
    const bf16* U = wsb(p, WS_U); const float* mu = p.in[I_MU] + l * 1024; float* STR = wsf(p, WS_STR);
    for (int grp = BIDX; grp < MR / 16; grp += GDIM) {
        for (int i = 0; i < 32; ++i) { const int e = tid + NTHR * i, tok = e >> 10, col = e & 1023, row = grp * 16 + tok;
            const float u = bf2f(U[(size_t)row * INC + UC_R + col]); float pv;
            if (row < MP) pv = (row & 4095) == 0 ? 0.f : bf2f(U[(size_t)(row - 1) * INC + UC_R + col]);
            else { const int rs = row - MP; pv = (rs & 3) == 0 ? p.in[I_SSHIFT][(size_t)(l * NBS + (rs >> 2)) * 1024 + col] : bf2f(U[(size_t)(row - 1) * INC + UC_R + col]); }
            float x = u + (pv - u) * mu[col];
            if (col >= 768 && col < 832) x = tanhf(x); else if (col >= 896) x = sigmoid_f(x);
            xs[e] = x; }
        __syncthreads();
        float aw[8], aa[8], ag[8];
#pragma unroll
        for (int t = 0; t < 8; ++t) { aw[t] = 0.f; aa[t] = 0.f; ag[t] = 0.f; }
        const float* w2 = p.in[I_W2] + (size_t)l * 64 * 256 + c; const float* a2 = p.in[I_A2] + (size_t)l * 64 * 256 + c; const float* g2 = p.in[I_G2] + (size_t)l * 128 * 256 + c;
        for (int k = 0; k < 64; ++k) { const float wv = w2[k * 256], av = a2[k * 256];
#pragma unroll
            for (int t = 0; t < 8; ++t) { aw[t] += xs[(half * 8 + t) * 1024 + 768 + k] * wv; aa[t] += xs[(half * 8 + t) * 1024 + 832 + k] * av; } }
        for (int k = 0; k < 128; ++k) { const float gv = g2[k * 256];
#pragma unroll
            for (int t = 0; t < 8; ++t) ag[t] += xs[(half * 8 + t) * 1024 + 896 + k] * gv; }
        const float w0 = p.in[I_W0][l * 256 + c], a0 = p.in[I_A0][l * 256 + c], kkw = p.in[I_KK][l * 256 + c], kaw = p.in[I_KA][l * 256 + c];
#pragma unroll
        for (int t = 0; t < 8; ++t) { const int tok = half * 8 + t, row = grp * 16 + tok;
            const float r = xs[tok * 1024 + c], k = xs[tok * 1024 + 256 + c], v = xs[tok * 1024 + 512 + c];
            const float wlog = -0.6065306597126334f * sigmoid_f(w0 + aw[t]); const float a = sigmoid_f(a0 + aa[t]);
            float kk = k * kkw; const float nrm = sqrtf(wave_sum(kk * kk)); kk = kk / fmaxf(nrm, 1e-12f);
            const float kp = k * (1.0f + (a - 1.0f) * kaw);
            const size_t o = (size_t)row * 256 + c;
            STR[S_W * STR_STRIDE + o] = __expf(wlog); STR[S_KK * STR_STRIDE + o] = kk; STR[S_KA * STR_STRIDE + o] = kk * a; STR[S_KP * STR_STRIDE + o] = kp;
            STR[S_R * STR_STRIDE + o] = r; STR[S_V * STR_STRIDE + o] = v; STR[S_G * STR_STRIDE + o] = ag[t]; }
        __syncthreads();
    }
}
__device__ __forceinline__ void ph_rwkv_scan(const P& p, int l, LAS unsigned char* lds, const int unit) {
    LAS float (*st)[8][64] = (LAS float (*)[8][64])lds;
    const int seq = unit >> 2, h = unit & 3, lane = TIDX & 63;
    const float* STR = wsf(p, WS_STR); float* YR = wsf(p, WS_YR);
    const int row0 = seq < NBP ? seq * TP : MP + (seq - NBP) * TS, nsteps = seq < NBP ? TP : TS;
    float S[64];
    if (seq < NBP) {
#pragma unroll
        for (int k = 0; k < 64; ++k) S[k] = 0.f;
    } else { const float* s0 = p.in[I_SWKV] + ((size_t)((l * NBS + (seq - NBP)) * 4 + h) * 64 + lane) * 64;
#pragma unroll
        for (int k = 0; k < 64; ++k) S[k] = s0[k]; }
    for (int t0 = 0; t0 < nsteps; t0 += 8) {
        float vv[8];
#pragma unroll
        for (int i = 0; i < 8; ++i) { const bool ok = t0 + i < nsteps; const size_t o = (size_t)(row0 + (ok ? t0 + i : 0)) * 256 + h * 64 + lane;
            st[0][i][lane] = STR[S_W * STR_STRIDE + o]; st[1][i][lane] = STR[S_KK * STR_STRIDE + o]; st[2][i][lane] = STR[S_KA * STR_STRIDE + o];
            st[3][i][lane] = STR[S_KP * STR_STRIDE + o]; st[4][i][lane] = STR[S_R * STR_STRIDE + o]; vv[i] = STR[S_V * STR_STRIDE + o]; }
        asm volatile("s_waitcnt vmcnt(0) lgkmcnt(0)" ::: "memory");
#pragma unroll
        for (int i = 0; i < 8; ++i) { if (t0 + i < nsteps) {
            float d0 = 0.f, d1 = 0.f;
#pragma unroll
            for (int k = 0; k < 64; k += 4) { const f32x4 q = *(const LAS f32x4*)&st[1][i][k]; d0 += S[k] * q.x; d1 += S[k + 1] * q.y; d0 += S[k + 2] * q.z; d1 += S[k + 3] * q.w; }
            const float d = d0 + d1, v = vv[i]; float y0 = 0.f, y1 = 0.f;
#pragma unroll
            for (int k = 0; k < 64; k += 4) { const f32x4 w = *(const LAS f32x4*)&st[0][i][k], ka = *(const LAS f32x4*)&st[2][i][k], kp = *(const LAS f32x4*)&st[3][i][k], r = *(const LAS f32x4*)&st[4][i][k];
                S[k] = S[k] * w.x - d * ka.x + v * kp.x; S[k + 1] = S[k + 1] * w.y - d * ka.y + v * kp.y; S[k + 2] = S[k + 2] * w.z - d * ka.z + v * kp.z; S[k + 3] = S[k + 3] * w.w - d * ka.w + v * kp.w;
                y0 += S[k] * r.x; y1 += S[k + 1] * r.y; y0 += S[k + 2] * r.z; y1 += S[k + 3] * r.w; }
            YR[(size_t)(row0 + t0 + i) * 256 + h * 64 + lane] = y0 + y1; } }
        asm volatile("s_waitcnt lgkmcnt(0)" ::: "memory");
    }
    float* so = p.out + (seq < NBP ? O_WKVP + ((size_t)((l * NBP + seq) * 4 + h) * 64 + lane) * 64 : O_WKVS + ((size_t)((l * NBS + (seq - NBP)) * 4 + h) * 64 + lane) * 64);
#pragma unroll
    for (int k = 0; k < 64; k += 4) *(f32x4*)(so + k) = (f32x4){S[k], S[k + 1], S[k + 2], S[k + 3]};
}
__device__ __forceinline__ void ph_rwkv_post(const P& p, int l) {
    const int lane = TIDX & 63, gw = BIDX * NWAVES + (TIDX >> 6), NGW = GDIM * NWAVES;
    const float* STR = wsf(p, WS_STR); const float* YR = wsf(p, WS_YR);
    for (int u = gw; u < MR * 4; u += NGW) { const int row = u >> 2, h = u & 3, c = h * 64 + lane; const size_t o = (size_t)row * 256 + c;
        const float y = YR[o], mean = wave_sum(y) * (1.f / 64.f), d = y - mean, var = wave_sum(d * d) * (1.f / 64.f);
        const float yn = d * (1.0f / sqrtf(var + 64e-5f)) * p.in[I_LNG][l * 256 + c] + p.in[I_LNB][l * 256 + c];
        const float bon = wave_sum(STR[S_R * STR_STRIDE + o] * STR[S_KP * STR_STRIDE + o] * p.in[I_RK][l * 256 + c]) * STR[S_V * STR_STRIDE + o];
        wsb(p, WS_MIX)[(size_t)row * DM + 256 + c] = (bf16)f2bf((yn + bon) * STR[S_G * STR_STRIDE + o]); }
}
__device__ __forceinline__ void ph_copy_out(const P& p, int l) {
    const bf16* U = wsb(p, WS_U); const int gt = BIDX * NTHR + TIDX, NT = GDIM * NTHR;
    for (int idx = gt; idx < NBP * WINB * 256; idx += NT) { const int c4 = (idx & 255) * 4, i = (idx >> 8) & 2047, n = idx >> 19;
        const int isv = c4 >= 512, cc = c4 & 511; const u32x2 a = *(const u32x2*)(U + (size_t)(n * TP + (TP - WINB) + i) * INC + (isv ? UC_AV : UC_AK) + cc);
        *(f32x4*)(p.out + (isv ? O_VP : O_KP) + ((size_t)(l * NBP + n) * WINB + i) * 512 + cc) = (f32x4){bf2f(a.x & 0xffffu), bf2f(a.x >> 16), bf2f(a.y & 0xffffu), bf2f(a.y >> 16)}; }
    for (int idx = gt; idx < MS * 256; idx += NT) { const int c4 = (idx & 255) * 4, rs = idx >> 8; const int isv = c4 >= 512, cc = c4 & 511;
        const u32x2 a = *(const u32x2*)(U + (size_t)(MP + rs) * INC + (isv ? UC_AV : UC_AK) + cc);
        *(f32x4*)(p.out + (isv ? O_VS : O_KS) + ((size_t)l * MS + rs) * 512 + cc) = (f32x4){bf2f(a.x & 0xffffu), bf2f(a.x >> 16), bf2f(a.y & 0xffffu), bf2f(a.y >> 16)}; }
    for (int idx = gt; idx < NSEQ * 256; idx += NT) { const int c4 = (idx & 255) * 4, s = idx >> 8; const int row = s < NBP ? s * TP + TP - 1 : MP + (s - NBP) * TS + TS - 1;
        const u32x2 a = *(const u32x2*)(U + (size_t)row * INC + UC_R + c4);
        float* o = s < NBP ? p.out + O_SHP + (size_t)(l * NBP + s) * 1024 + c4 : p.out + O_SHS + (size_t)(l * NBS + (s - NBP)) * 1024 + c4;
        *(f32x4*)o = (f32x4){bf2f(a.x & 0xffffu), bf2f(a.x >> 16), bf2f(a.y & 0xffffu), bf2f(a.y >> 16)}; }
}
__device__ __forceinline__ int rel_bucket(int dist) {
    if (dist < 16) return dist;
    const float d = (float)dist; int lg = 16 + (int)(logf(d / 16.0f) / logf(128.0f) * 16.0f); return lg < 31 ? lg : 31;
}
__device__ __forceinline__ void ph_attn_p(const P& p, LAS unsigned char* lds) {
    LAS float* btab = (LAS float*)lds;
    constexpr int VROW = 144, VB = 32 * VROW;
    const int tid = TIDX, lane = tid & 63, wave = tid >> 6, fr = lane & 15, g = lane >> 4;
    LAS unsigned char* vst = lds + 3 * 129 * 8 * 4 + wave * VB;
    for (int e = tid; e < 3 * 129; e += NTHR) { const int br = e / 129, dl = e % 129, dil = br == 0 ? 1 : (br == 1 ? 4 : 16); const int b = rel_bucket(dl * dil);
        for (int h = 0; h < 8; ++h) btab[e * 8 + h] = p.in[I_RELB][b * 8 + h]; }
    __syncthreads();
    const bf16* U = wsb(p, WS_U); float* OP = wsf(p, WS_OP); float* ML = wsf(p, WS_ML);
    const int gw = BIDX * NWAVES + wave, NGW = GDIM * NWAVES;
    for (int u = gw; u < 3 * NBP * 8 * 256; u += NGW) {
        const int br = u / 8192, rem = u % 8192, n = rem / 2048, h = (rem % 2048) / 256, rq = rem % 256;
        const int dil = br == 0 ? 1 : (br == 1 ? 4 : 16), tpr = 256 / dil, r = rq / tpr, qt = rq % tpr, j0 = 16 * qt, L = TP / dil;
        const size_t rowb = (size_t)n * TP;
        bf16x8 qf[2];
        { const bf16* qp = U + (rowb + (size_t)(j0 + fr) * dil + r) * INC + UC_AQ + h * 64 + 8 * g; qf[0] = *(const bf16x8*)qp; qf[1] = *(const bf16x8*)(qp + 32); }
        float sc[9][4]; float mx = -1e30f;
#pragma unroll
        for (int kt = 0; kt < 9; ++kt) {
            int kj = j0 - 128 + 16 * kt + fr; kj = kj < 0 ? 0 : kj;
            const bf16* kp = U + (rowb + (size_t)kj * dil + r) * INC + UC_AK + h * 64 + 8 * g;
            const bf16x8 k0 = *(const bf16x8*)kp, k1 = *(const bf16x8*)(kp + 32);
            f32x4 acc = {0.f, 0.f, 0.f, 0.f};
            acc = __builtin_amdgcn_mfma_f32_16x16x32_bf16(k0, qf[0], acc, 0, 0, 0);
            acc = __builtin_amdgcn_mfma_f32_16x16x32_bf16(k1, qf[1], acc, 0, 0, 0);
#pragma unroll
            for (int rg = 0; rg < 4; ++rg) { const int kjr = j0 - 128 + 16 * kt + 4 * g + rg, dl = j0 + fr - kjr; const bool ok = dl >= 0 && dl <= 128 && kjr >= 0;
                const float s = ok ? acc[rg] * 0.125f + btab[(br * 129 + (ok ? dl : 0)) * 8 + h] : -1e30f; sc[kt][rg] = s; mx = fmaxf(mx, s); }
        }
        mx = fmaxf(mx, __shfl_xor(mx, 16)); mx = fmaxf(mx, __shfl_xor(mx, 32));
        float lsum = 0.f;
#pragma unroll
        for (int kt = 0; kt < 9; ++kt)
#pragma unroll
            for (int rg = 0; rg < 4; ++rg) { const float e = __expf(sc[kt][rg] - mx); sc[kt][rg] = e; lsum += e; }
        lsum += __shfl_xor(lsum, 16); lsum += __shfl_xor(lsum, 32);
        f32x4 o[4];
#pragma unroll
        for (int dt = 0; dt < 4; ++dt) o[dt] = (f32x4){0.f, 0.f, 0.f, 0.f};
#pragma unroll
        for (int ks = 0; ks < 5; ++ks) {
#pragma unroll
            for (int i4 = 0; i4 < 4; ++i4) { const int ri = (lane >> 3) + 8 * i4; int kj = j0 - 128 + 32 * ks + ri; kj = kj < 0 ? 0 : (kj > L - 1 ? L - 1 : kj);
                const u32x4 v = *(const u32x4*)(U + (rowb + (size_t)kj * dil + r) * INC + UC_AV + h * 64 + (lane & 7) * 8);
                *(LAS u32x4*)(vst + ri * VROW + (lane & 7) * 16) = v; }
            asm volatile("s_waitcnt lgkmcnt(0)" ::: "memory");
            bf16x8 pf;
            { const unsigned a0 = pk2(sc[2 * ks][0], sc[2 * ks][1]), a1 = pk2(sc[2 * ks][2], sc[2 * ks][3]);
              unsigned a2 = 0u, a3 = 0u; if (ks < 4) { a2 = pk2(sc[2 * ks + 1 < 9 ? 2 * ks + 1 : 8][0], sc[2 * ks + 1 < 9 ? 2 * ks + 1 : 8][1]); a3 = pk2(sc[2 * ks + 1 < 9 ? 2 * ks + 1 : 8][2], sc[2 * ks + 1 < 9 ? 2 * ks + 1 : 8][3]); }
              const u32x4 t = {a0, a1, a2, a3}; pf = __builtin_bit_cast(bf16x8, t); }
#pragma unroll
            for (int dt = 0; dt < 4; ++dt) {
                LAS unsigned char* a = vst + (4 * g + (fr >> 2)) * VROW + (16 * dt + 4 * (fr & 3)) * 2;
                const s16x4 lo = __builtin_bit_cast(s16x4, __builtin_amdgcn_ds_read_tr16_b64_v4i16((LAS s16x4*)a));
                const s16x4 hi = __builtin_bit_cast(s16x4, __builtin_amdgcn_ds_read_tr16_b64_v4i16((LAS s16x4*)(a + 16 * VROW)));
                const bf16x8 vf = {lo[0], lo[1], lo[2], lo[3], hi[0], hi[1], hi[2], hi[3]};
                o[dt] = __builtin_amdgcn_mfma_f32_16x16x32_bf16(pf, vf, o[dt], 0, 0, 0); }
            asm volatile("s_waitcnt lgkmcnt(0)" ::: "memory");
        }
#pragma unroll
        for (int rg = 0; rg < 4; ++rg) { const size_t row = rowb + (size_t)(j0 + 4 * g + rg) * dil + r;
#pragma unroll
            for (int dt = 0; dt < 4; ++dt) OP[((size_t)br * MP + row) * 512 + h * 64 + 16 * dt + fr] = o[dt][rg]; }
        if (g == 0) { const size_t row = rowb + (size_t)(j0 + fr) * dil + r; float* ml = ML + (((size_t)br * MP + row) * 8 + h) * 2; ml[0] = mx; ml[1] = lsum; }
    }
}
__device__ __forceinline__ void ph_attn_merge(const P& p, const int b0, const int nb) {
    const float* OP = wsf(p, WS_OP); const float* ML = wsf(p, WS_ML); const int gt = b0 * NTHR + TIDX, NT = nb * NTHR;
    for (int idx = gt; idx < MP * 128; idx += NT) { const int row = idx >> 7, c4 = (idx & 127) * 4, h = c4 >> 6;
        float m[3], l[3]; float M = -1e30f;
#pragma unroll
        for (int b = 0; b < 3; ++b) { m[b] = ML[(((size_t)b * MP + row) * 8 + h) * 2]; l[b] = ML[(((size_t)b * MP + row) * 8 + h) * 2 + 1]; M = fmaxf(M, m[b]); }
        f32x4 num = {0.f, 0.f, 0.f, 0.f}; float den = 0.f;
#pragma unroll
        for (int b = 0; b < 3; ++b) { const float w = __expf(m[b] - M); den += w * l[b]; num += *(const f32x4*)(OP + ((size_t)b * MP + row) * 512 + c4) * w; }
        const float inv = 1.0f / den; u32x2 w; w.x = pk2(num.x * inv, num.y * inv); w.y = pk2(num.z * inv, num.w * inv);
        *(u32x2*)(wsb(p, WS_MIX) + (size_t)row * DM + 512 + c4) = w; }
}
__device__ __forceinline__ void ph_attn_s(const P& p, int l) {
    const int lane = TIDX & 63, sub = lane & 15, ks = lane >> 4, gw = BIDX * NWAVES + (TIDX >> 6), NGW = GDIM * NWAVES;
    const bf16* U = wsb(p, WS_U);
    for (int u = gw; u < NBS * TS * 8; u += NGW) { const int h = u & 7, s = (u >> 3) & 3, n = u >> 5; const int row = MP + n * TS + s;
        f32x4 q; { const u32x2 a = *(const u32x2*)(U + (size_t)row * INC + UC_AQ + h * 64 + 4 * sub); q = (f32x4){bf2f(a.x & 0xffffu), bf2f(a.x >> 16), bf2f(a.y & 0xffffu), bf2f(a.y >> 16)}; }
        float mr = -1e30f, lr = 0.f; f32x4 o = {0.f, 0.f, 0.f, 0.f};
#pragma unroll 1
        for (int br = 0; br < 3; ++br) { const int dil = br == 0 ? 1 : (br == 1 ? 4 : 16);
#pragma unroll 1
            for (int it = 0; it < 33; ++it) { const int m = 4 * it + ks; const bool ok = m <= 128; const int idx = WINB + s - (ok ? m : 0) * dil;
                f32x4 kv, vv;
                if (idx >= WINB) { const size_t ro = (size_t)(MP + n * TS + (idx - WINB)) * INC + h * 64 + 4 * sub; const u32x2 a = *(const u32x2*)(U + ro + UC_AK), b = *(const u32x2*)(U + ro + UC_AV);
                    kv = (f32x4){bf2f(a.x & 0xffffu), bf2f(a.x >> 16), bf2f(a.y & 0xffffu), bf2f(a.y >> 16)}; vv = (f32x4){bf2f(b.x & 0xffffu), bf2f(b.x >> 16), bf2f(b.y & 0xffffu), bf2f(b.y >> 16)}; }
                else { const size_t co = (((size_t)(l * NBS + n) * WINB + idx) * 8 + h) * 64 + 4 * sub; kv = *(const f32x4*)(p.in[I_CK] + co); vv = *(const f32x4*)(p.in[I_CV] + co); }
                float d = (q.x * kv.x + q.y * kv.y) + (q.z * kv.z + q.w * kv.w);
                d += __shfl_xor(d, 1); d += __shfl_xor(d, 2); d += __shfl_xor(d, 4); d += __shfl_xor(d, 8);
                if (ok) { const float sc = d * 0.125f + p.in[I_RELB][rel_bucket(m * dil) * 8 + h]; const float mn = fmaxf(mr, sc), cr = __expf(mr - mn), pe = __expf(sc - mn);
                    lr = lr * cr + pe; o = o * cr + vv * pe; mr = mn; }
            } }
#pragma unroll
        for (int x = 16; x < 64; x <<= 1) { const float m2 = __shfl_xor(mr, x), l2 = __shfl_xor(lr, x); f32x4 o2; o2.x = __shfl_xor(o.x, x); o2.y = __shfl_xor(o.y, x); o2.z = __shfl_xor(o.z, x); o2.w = __shfl_xor(o.w, x);
            const float mn = fmaxf(mr, m2), c1 = __expf(mr - mn), c2 = __expf(m2 - mn); lr = lr * c1 + l2 * c2; o = o * c1 + o2 * c2; mr = mn; }
        if (ks == 0) { const float inv = 1.0f / lr; u32x2 w; w.x = pk2(o.x * inv, o.y * inv); w.y = pk2(o.z * inv, o.w * inv); *(u32x2*)(wsb(p, WS_MIX) + (size_t)row * DM + 512 + h * 64 + 4 * sub) = w; }
    }
}

constexpr int LDSCTL_OFF = 131072, LDS_BYTES = 147456, CW_BAR = 1024;
constexpr size_t CTL_ZERO_BYTES = 65536;
constexpr int SCAN_UNITS = NSEQ * 4;
#define GRID_BAR() do { XcdBarrier b_; b_.bar = (unsigned*)(argp().ws + WS_CTL) + CW_BAR; b_.x = xb_xcc_id(); b_.st = (volatile LAS unsigned*)(lds + LDSCTL_OFF + 32); xcd_barrier(b_); } while (0)
__device__ __forceinline__ const P& argp() { const void* q = (const void*)__builtin_amdgcn_kernarg_segment_ptr(); asm volatile("" : "+s"(q) :: "memory"); return *(const P*)q; }
__global__ void __launch_bounds__(NTHR, 2) fwd(P p_) {
    extern __shared__ __attribute__((aligned(16))) unsigned char lds_raw[];
    LAS unsigned char* lds = (LAS unsigned char*)lds_raw;
    if (threadIdx.x < 64) ((LAS unsigned*)(lds + LDSCTL_OFF))[threadIdx.x] = 0u;
    __syncthreads();
    (void)xcd_barrier_post((unsigned*)(p_.ws + WS_CTL) + CW_BAR, (volatile LAS unsigned*)(lds + LDSCTL_OFF + 32));
    const int G = gridDim.x, bx = blockIdx.x;
    ph_transpose(argp(), lds); ph_silu(argp());
    GRID_BAR();
    ph_mod(argp(), lds);
    GRID_BAR();
    ph_norm0(argp());
    GRID_BAR();
    for (int l_ = 0; l_ < NL; ++l_) {
        ph_gemm<0>(argp(), opaque_s(l_), lds);
        GRID_BAR();
        ph_glu(argp(), opaque_s(l_)); ph_copy_out(argp(), opaque_s(l_)); ph_attn_s(argp(), opaque_s(l_));
        ph_rwkv_prep(argp(), opaque_s(l_), lds); __syncthreads();
        ph_attn_p(argp(), lds);
        GRID_BAR();
        if (bx < SCAN_UNITS) { if (threadIdx.x < 64) ph_rwkv_scan(argp(), opaque_s(l_), lds, opaque_s(bx)); }
        else { ph_conv(argp(), opaque_s(l_), lds, opaque_s(bx - SCAN_UNITS), opaque_s(G - SCAN_UNITS)); ph_attn_merge(argp(), opaque_s(bx - SCAN_UNITS), opaque_s(G - SCAN_UNITS)); }
        GRID_BAR();
        ph_rwkv_post(argp(), opaque_s(l_));
        GRID_BAR();
        ph_gemm<1>(argp(), opaque_s(l_), lds);
        GRID_BAR();
        ph_resid(argp(), opaque_s(l_), 0);
        GRID_BAR();
        ph_gemm<2>(argp(), opaque_s(l_), lds);
        GRID_BAR();
        ph_gemm<3>(argp(), opaque_s(l_), lds);
        GRID_BAR();
        ph_resid(argp(), opaque_s(l_), 1);
        if (l_ + 1 < NL) GRID_BAR();
    }
}

extern "C" void kernel_launch(void* const* d_in, const int* in_sizes, int n_in, void* d_out, int out_size, void* d_ws, size_t ws_size, hipStream_t stream) {
    static int grid = 0;
    if (grid == 0) {
        if (n_in != N_IN || (size_t)out_size != O_END || ws_size < WS_END) { fprintf(stderr, "kernel_launch: unexpected sizes n_in %d out %d ws %zu (want %d %zu %zu)\n", n_in, out_size, ws_size, (int)N_IN, (size_t)O_END, (size_t)WS_END); grid = -1; return; }
        int dev = 0, cus = 0, per_cu = 0;
        if (hipGetDevice(&dev) != hipSuccess || hipDeviceGetAttribute(&cus, hipDeviceAttributeMultiprocessorCount, dev) != hipSuccess) { grid = -1; return; }
        if (hipFuncSetAttribute((const void*)fwd, hipFuncAttributeMaxDynamicSharedMemorySize, LDS_BYTES) != hipSuccess) { fprintf(stderr, "kernel_launch: hipFuncSetAttribute failed\n"); grid = -1; return; }
        if (hipOccupancyMaxActiveBlocksPerMultiprocessor(&per_cu, (const void*)fwd, NTHR, LDS_BYTES) != hipSuccess || per_cu < 1) fprintf(stderr, "kernel_launch: occupancy query says %d\n", per_cu);
        (void)hipGetLastError();
        grid = cus;
        if (grid != 256) fprintf(stderr, "kernel_launch: %d CUs (expected 256)\n", grid);
    }
    if (grid < 0) return;
    (void)hipMemsetAsync((char*)d_ws + WS_CTL, 0, CTL_ZERO_BYTES, stream);
    P p{}; for (int i = 0; i < N_IN; ++i) p.in[i] = (const float*)d_in[i]; p.out = (float*)d_out; p.ws = (unsigned char*)d_ws;
    hipLaunchKernelGGL(fwd, dim3(grid), dim3(NTHR), LDS_BYTES, stream, p);
}
```

```cpp
#include <hip/hip_runtime.h>
#include <cstdio>
#include <cstdint>

__device__ __forceinline__ int opaque_v(int x) { asm volatile("" : "+v"(x)); return x; }
__device__ __forceinline__ int opaque_s(int x) { asm volatile("" : "+s"(x)); return x; }
#define TIDX opaque_v((int)threadIdx.x)
#define BIDX opaque_s((int)blockIdx.x)
#define GDIM opaque_s((int)gridDim.x)
namespace pg8 {
#define PG8_LAS __attribute__((address_space(3)))
typedef unsigned short bf16_t;
typedef short bf16x8 __attribute__((ext_vector_type(8)));
typedef float f32x4 __attribute__((ext_vector_type(4)));
typedef unsigned u32x4 __attribute__((ext_vector_type(4)));
constexpr int BM = 256, BK = 64, HALF = 128, HTB = HALF * BK * 2  , STAGE_BYTES = 8 * HTB, NXCD = 8, WGM = 8;

__host__ __device__ __forceinline__ int lds_byte(int r, int c) { const int st = (r >> 4) * 2 + (c >> 5), rr = r & 15, cc = c & 31, ob = rr * 64 + cc * 2; return st * 1024 + (ob ^ (((ob >> 9) & 1) << 5)); }
__host__ __device__ __forceinline__ void stage_rc(int b, int& R, int& C) { const int st = b / 1024, sb = b % 1024, swz = sb ^ (((sb >> 9) & 1) << 5); R = (st >> 1) * 16 + swz / 64; C = (st & 1) * 32 + (swz % 64) / 2; }
__host__ __device__ __forceinline__ int perm32(int rho) { const int n = rho >> 4, i = rho & 15; return 8 * (i >> 2) + 4 * n + (i & 3); }

struct Unit { int pm, pn; };
struct Gemm { const bf16_t* A; const bf16_t* Bt; int M, N, K; };

struct StaticOrder {
    int nM, nN, nwg, G, c;
    __host__ __device__ void init(int M, int N, int G_, int c_) { nM = M / BM; nN = N / BM; nwg = nM * nN; G = G_; c = c_; }
    __host__ __device__ bool next(int i, Unit& u) const {
        const long L = (long)i * G + c; if (L >= nwg) return false;
        int wgid = (int)L; { const int q = nwg / NXCD, r = nwg % NXCD, xcd = wgid % NXCD, off = wgid / NXCD; wgid = (xcd < r ? xcd * (q + 1) : r * (q + 1) + (xcd - r) * q) + off; }
        const int nig = WGM * nN, gid = wgid / nig, fm = gid * WGM, gsz = (nM - fm) < WGM ? (nM - fm) : WGM;
        u.pm = fm + ((wgid % nig) % gsz); u.pn = (wgid % nig) / gsz; return true;
    }
    __device__ __forceinline__ void a_ready(const Unit&) const {}
    __device__ __forceinline__ void done(const Unit&) const {}
};

__device__ __forceinline__ unsigned cvt_pk_bf16(float lo, float hi) { unsigned r; asm volatile("v_cvt_pk_bf16_f32 %0, %1, %2" : "=v"(r) : "v"(lo), "v"(hi)); return r; }
typedef float f32x2 __attribute__((ext_vector_type(2)));
struct EpiBf16 {
    static constexpr bool PERM = true, AFTER_DRAIN = false;
    bf16_t* O; int ldc;
    __device__ __forceinline__ void operator()(const f32x4 (&acc)[2][2][4][2], const Unit& u, int wr, int wc, int fr, int fq) const {
        const int row0 = u.pm * BM + wr * 64 + fr; const int col0 = u.pn * BM + wc * 32 + 8 * fq;
#pragma unroll
        for (int ai = 0; ai < 2; ++ai)
#pragma unroll
            for (int m = 0; m < 4; ++m) { bf16_t* rowp = O + (size_t)(row0 + ai * HALF + m * 16) * ldc + col0;
#pragma unroll
                for (int bj = 0; bj < 2; ++bj) { const f32x4 v0 = acc[ai][bj][m][0], v1 = acc[ai][bj][m][1];
                    u32x4 w; w.x = cvt_pk_bf16(v0[0], v0[1]); w.y = cvt_pk_bf16(v0[2], v0[3]); w.z = cvt_pk_bf16(v1[0], v1[1]); w.w = cvt_pk_bf16(v1[2], v1[3]);
                    *(u32x4*)(rowp + bj * HALF) = w; } }
    }
};
struct EpiF32 {
    static constexpr bool PERM = false, AFTER_DRAIN = false;
    float* C; int ldc;
    __device__ __forceinline__ void operator()(const f32x4 (&acc)[2][2][4][2], const Unit& u, int wr, int wc, int fr, int fq) const {
        const int row0 = u.pm * BM + wr * 64 + fr, col0 = u.pn * BM + wc * 32 + 4 * fq;
#pragma unroll
        for (int ai = 0; ai < 2; ++ai)
#pragma unroll
            for (int m = 0; m < 4; ++m) { float* rowp = C + (size_t)(row0 + ai * HALF + m * 16) * ldc + col0;
#pragma unroll
                for (int bj = 0; bj < 2; ++bj)
#pragma unroll
                    for (int n = 0; n < 2; ++n) *(f32x4*)(rowp + bj * HALF + n * 16) = acc[ai][bj][m][n]; }
    }
};
__device__ __forceinline__ float silu_f(float x) { return x / (1.0f + __expf(-x)); }
struct EpiSwiGLU {
    static constexpr bool PERM = true, AFTER_DRAIN = false;
    bf16_t* O; int ldc;
    __device__ __forceinline__ void operator()(const f32x4 (&acc)[2][2][4][2], const Unit& u, int wr, int wc, int fr, int fq) const {
        const int row0 = u.pm * BM + wr * 64 + fr; const int col0 = u.pn * HALF + wc * 32 + 8 * fq;
#pragma unroll
        for (int ai = 0; ai < 2; ++ai)
#pragma unroll
            for (int m = 0; m < 4; ++m) { bf16_t* rowp = O + (size_t)(row0 + ai * HALF + m * 16) * ldc + col0;
                const f32x4 g0 = acc[ai][0][m][0], g1 = acc[ai][0][m][1], u0 = acc[ai][1][m][0], u1 = acc[ai][1][m][1];
                f32x4 v0, v1;
#pragma unroll
                for (int j = 0; j < 4; ++j) { v0[j] = silu_f(g0[j]) * u0[j]; v1[j] = silu_f(g1[j]) * u1[j]; }
                u32x4 w; w.x = cvt_pk_bf16(v0[0], v0[1]); w.y = cvt_pk_bf16(v0[2], v0[3]); w.z = cvt_pk_bf16(v1[0], v1[1]); w.w = cvt_pk_bf16(v1[2], v1[3]);
                *(u32x4*)rowp = w; }
    }
};
template <class Epi, class Sched, bool ALIGN_EPI = false, bool SP2 = false>
__device__ __forceinline__ void gemm_phase(PG8_LAS unsigned char* lds, const Gemm g, const Sched& S, const Epi& E) {
    const int tid = TIDX, wid = __builtin_amdgcn_readfirstlane(tid >> 6), lane = tid & 63, wr = wid >> 2, wc = wid & 3, fr = lane & 15, fq = lane >> 4;
    const int K = g.K, nt = K / BK;
    unsigned voffA[2], voffB[2];
#pragma unroll
    for (int i = 0; i < 2; ++i) { int R, C; stage_rc(tid * 16 + i * 8192, R, C); const int Rb = Epi::PERM ? ((R & ~31) + perm32(R & 31)) : R;
        voffA[i] = (unsigned)(R * K + C) * 2u; voffB[i] = (unsigned)(Rb * K + C) * 2u; }
    const size_t kstep = (size_t)(BK * 2);
    const size_t hstep = (size_t)HALF * K * 2;
    const size_t tstep = 2 * hstep;
    const unsigned ldsw = (unsigned)wid * 1024u;
    const int aoff = lds_byte(wr * 64 + fr, fq * 8), boff = lds_byte(wc * 32 + fr, fq * 8);
#define PG8_SA(b, h) (((b) * 2 + (h)) * HTB)
#define PG8_SB(b, h) ((4 + (b) * 2 + (h)) * HTB)
#define PG8_STAGE(bufoff, gbase, voff) do { _Pragma("unroll") for (int _i = 0; _i < 2; ++_i) \
        __builtin_amdgcn_global_load_lds((const unsigned*)((const char*)(gbase) + (voff)[_i]), (PG8_LAS unsigned*)(lds + (bufoff) + ldsw + _i * 8192), 16, 0, 0); } while (0)
#define PG8_LDA(dst, b, h) do { _Pragma("unroll") for (int m = 0; m < 4; ++m) _Pragma("unroll") for (int k = 0; k < 2; ++k) dst[m][k] = *(const PG8_LAS bf16x8*)(lds + PG8_SA(b, h) + aoff + m * 2048 + k * 1024); } while (0)
#define PG8_LDB(dst, b, h) do { _Pragma("unroll") for (int n = 0; n < 2; ++n) _Pragma("unroll") for (int k = 0; k < 2; ++k) dst[n][k] = *(const PG8_LAS bf16x8*)(lds + PG8_SB(b, h) + boff + n * 2048 + k * 1024); } while (0)
#define PG8_MMA(ai, bj, At, Bt) do { __builtin_amdgcn_s_setprio(1); _Pragma("unroll") for (int m = 0; m < 4; ++m) _Pragma("unroll") for (int n = 0; n < 2; ++n) _Pragma("unroll") for (int k = 0; k < 2; ++k) \
        acc[ai][bj][m][n] = __builtin_amdgcn_mfma_f32_16x16x32_bf16(Bt[n][k], At[m][k], acc[ai][bj][m][n], 0, 0, 0); __builtin_amdgcn_s_setprio(0); } while (0)
#define PG8_WAIT_V(n) asm volatile("s_waitcnt vmcnt(" #n ")" ::: "memory")
#define PG8_WAIT_L(n) asm volatile("s_waitcnt lgkmcnt(" #n ")" ::: "memory")
#define PG8_BAR __builtin_amdgcn_s_barrier()
#define PG8_SCHED __builtin_amdgcn_sched_barrier(0)
    Unit cur, nxt; int ui = 0;
    if (!S.next(0, cur)) return;
    f32x4 acc[2][2][4][2];
#pragma unroll
    for (int a = 0; a < 2; ++a)
#pragma unroll
        for (int b = 0; b < 2; ++b)
#pragma unroll
            for (int m = 0; m < 4; ++m)
#pragma unroll
                for (int n = 0; n < 2; ++n) acc[a][b][m][n] = (f32x4){0.f, 0.f, 0.f, 0.f};
    bf16x8 At[4][2], B0[2][2], B1[2][2];
    const char* cA = (const char*)g.A + (size_t)cur.pm * tstep; const char* cB = (const char*)g.Bt + (size_t)cur.pn * tstep;
    S.a_ready(cur);
    if constexpr (SP2) {
        PG8_STAGE(PG8_SB(0, 0), cB, voffB); PG8_STAGE(PG8_SB(0, 1), cB + hstep, voffB); PG8_STAGE(PG8_SA(0, 0), cA, voffA); PG8_STAGE(PG8_SA(0, 1), cA + hstep, voffA);
        if (wr == 1) PG8_BAR;
        PG8_WAIT_V(2); PG8_BAR;
        PG8_STAGE(PG8_SB(1, 0), cB + kstep, voffB); PG8_STAGE(PG8_SA(1, 0), cA + kstep, voffA); PG8_STAGE(PG8_SB(1, 1), cB + hstep + kstep, voffB);
        PG8_WAIT_V(6); PG8_BAR;
    } else {
        PG8_STAGE(PG8_SB(0, 0), cB, voffB); PG8_STAGE(PG8_SA(0, 0), cA, voffA); PG8_STAGE(PG8_SB(0, 1), cB + hstep, voffB); PG8_STAGE(PG8_SA(0, 1), cA + hstep, voffA);
        if (wr == 1) PG8_BAR;
        PG8_WAIT_V(4); PG8_BAR;
        PG8_STAGE(PG8_SB(1, 0), cB + kstep, voffB); PG8_STAGE(PG8_SA(1, 0), cA + kstep, voffA); PG8_STAGE(PG8_SB(1, 1), cB + hstep + kstep, voffB);
        PG8_WAIT_V(6); PG8_BAR;
    }
    for (;;) {
        const bool has_next = S.next(ui + 1, nxt);
        const char* nA = has_next ? (const char*)g.A + (size_t)nxt.pm * tstep : cA; const char* nB = has_next ? (const char*)g.Bt + (size_t)nxt.pn * tstep : cB;
        for (int t = 0; t < nt; t += 2) {
            const bool last = (t == nt - 2);
            const char* a1 = cA + (size_t)(t + 1) * kstep;
            const char* a2 = last ? nA : cA + (size_t)(t + 2) * kstep; const char* b2 = last ? nB : cB + (size_t)(t + 2) * kstep;
            const char* a3 = a2 + kstep; const char* b3 = b2 + kstep;
            if (last && has_next) S.a_ready(nxt);
            if constexpr (SP2) {
            PG8_LDB(B0, 0, 0); PG8_LDB(B1, 0, 1); PG8_SCHED; PG8_LDA(At, 0, 0); PG8_STAGE(PG8_SA(1, 1), a1 + hstep, voffA);
            PG8_WAIT_V(8); PG8_WAIT_L(0); PG8_BAR; PG8_MMA(0, 0, At, B0); PG8_MMA(0, 1, At, B1); PG8_BAR; PG8_SCHED;
            PG8_LDA(At, 0, 1); PG8_STAGE(PG8_SB(0, 0), b2, voffB); PG8_STAGE(PG8_SB(0, 1), b2 + hstep, voffB); PG8_STAGE(PG8_SA(0, 0), a2, voffA);
            PG8_WAIT_V(8); PG8_WAIT_L(0); PG8_BAR; PG8_MMA(1, 0, At, B0); PG8_MMA(1, 1, At, B1); PG8_BAR; PG8_SCHED;
            PG8_LDB(B0, 1, 0); PG8_LDB(B1, 1, 1); PG8_SCHED; PG8_LDA(At, 1, 0); PG8_STAGE(PG8_SA(0, 1), a2 + hstep, voffA);
            PG8_WAIT_V(8); PG8_WAIT_L(0); PG8_BAR; PG8_MMA(0, 0, At, B0); PG8_MMA(0, 1, At, B1); PG8_BAR; PG8_SCHED;
            PG8_LDA(At, 1, 1); PG8_STAGE(PG8_SB(1, 0), b3, voffB); PG8_STAGE(PG8_SB(1, 1), b3 + hstep, voffB); PG8_STAGE(PG8_SA(1, 0), a3, voffA);
            PG8_WAIT_V(8); PG8_WAIT_L(0); PG8_BAR; PG8_MMA(1, 0, At, B0); PG8_MMA(1, 1, At, B1); PG8_BAR; PG8_SCHED;
            } else {
            PG8_LDB(B0, 0, 0); PG8_SCHED; PG8_LDA(At, 0, 0); PG8_STAGE(PG8_SA(1, 1), a1 + hstep, voffA);
            PG8_WAIT_L(8); PG8_BAR; PG8_WAIT_L(0); PG8_MMA(0, 0, At, B0); PG8_BAR; PG8_SCHED;
            PG8_LDB(B1, 0, 1); PG8_STAGE(PG8_SB(0, 0), b2, voffB);
            PG8_BAR; PG8_WAIT_L(0); PG8_MMA(0, 1, At, B1); PG8_BAR;
            PG8_LDA(At, 0, 1); PG8_STAGE(PG8_SA(0, 0), a2, voffA);
            PG8_BAR; PG8_WAIT_L(0); PG8_MMA(1, 0, At, B0); PG8_BAR; PG8_SCHED;
            PG8_STAGE(PG8_SB(0, 1), b2 + hstep, voffB);
            PG8_WAIT_V(6); PG8_BAR; PG8_MMA(1, 1, At, B1); PG8_BAR;
            PG8_LDB(B0, 1, 0); PG8_SCHED; PG8_LDA(At, 1, 0); PG8_STAGE(PG8_SA(0, 1), a2 + hstep, voffA);
            PG8_WAIT_L(8); PG8_BAR; PG8_WAIT_L(0); PG8_MMA(0, 0, At, B0); PG8_BAR; PG8_SCHED;
            PG8_LDB(B1, 1, 1); PG8_STAGE(PG8_SB(1, 0), b3, voffB);
            PG8_BAR; PG8_WAIT_L(0); PG8_MMA(0, 1, At, B1); PG8_BAR;
            PG8_LDA(At, 1, 1); PG8_STAGE(PG8_SA(1, 0), a3, voffA);
            PG8_BAR; PG8_WAIT_L(0); PG8_MMA(1, 0, At, B0); PG8_BAR; PG8_SCHED;
            PG8_STAGE(PG8_SB(1, 1), b3 + hstep, voffB);
            PG8_WAIT_V(6); PG8_BAR; PG8_MMA(1, 1, At, B1); PG8_BAR;
            }
        }
        if constexpr (ALIGN_EPI) { if (wr == 0) PG8_BAR; }
        if constexpr (!Epi::AFTER_DRAIN) { E(acc, cur, wr, wc, fr, fq); S.done(cur); }
        if (!has_next) break;
#pragma unroll
        for (int a = 0; a < 2; ++a)
#pragma unroll
            for (int b = 0; b < 2; ++b)
#pragma unroll
                for (int m = 0; m < 4; ++m)
#pragma unroll
                    for (int n = 0; n < 2; ++n) acc[a][b][m][n] = (f32x4){0.f, 0.f, 0.f, 0.f};
        cur = nxt; cA = nA; cB = nB; ++ui;
        if constexpr (ALIGN_EPI) { if (wr == 1) PG8_BAR; }
    }
    PG8_WAIT_V(0);
    if constexpr (!ALIGN_EPI) { if (wr == 0) PG8_BAR; }
    PG8_BAR;
    if constexpr (Epi::AFTER_DRAIN) { E.fused(acc, cur, wr, wc, fr, fq, lds, wid, lane); S.done(cur); }
#undef PG8_SA
#undef PG8_SB
#undef PG8_STAGE
#undef PG8_LDA
#undef PG8_LDB
#undef PG8_MMA
#undef PG8_WAIT_V
#undef PG8_WAIT_L
#undef PG8_BAR
#undef PG8_SCHED
}
}

constexpr int DM = 1024, NBP = 4, TP = 4096, NL = 4, NBS = 32, TS = 4;
constexpr int MP = NBP * TP, MS = NBS * TS, MR = MP + MS, MPAD = 16640, NSEQ = NBP + NBS;
constexpr int INC = 3072, FF = 2816, FF2 = 5632, CKW = 31, WINB = 2048;
constexpr int UC_CA = 0, UC_CG = 256, UC_R = 512, UC_AQ = 1536, UC_AK = 2048, UC_AV = 2560;
constexpr int NTHR = 512, NWAVES = 8;
constexpr size_t O_YP = 0, O_YS = O_YP + (size_t)MP * DM, O_CONVP = O_YS + (size_t)MS * DM, O_CONVS = O_CONVP + (size_t)NL * NBP * 30 * 256,
    O_SHP = O_CONVS + (size_t)NL * NBS * 30 * 256, O_SHS = O_SHP + (size_t)NL * NBP * 1024, O_WKVP = O_SHS + (size_t)NL * NBS * 1024,
    O_WKVS = O_WKVP + (size_t)NL * NBP * 4 * 4096, O_KP = O_WKVS + (size_t)NL * NBS * 4 * 4096, O_KS = O_KP + (size_t)NL * NBP * WINB * 512,
    O_VP = O_KS + (size_t)NL * NBS * TS * 512, O_VS = O_VP + (size_t)NL * NBP * WINB * 512, O_END = O_VS + (size_t)NL * NBS * TS * 512;
enum { I_XP = 0, I_XS, I_CP, I_CS, I_CCONV, I_SSHIFT, I_SWKV, I_CK, I_CV, I_WADA, I_BADA, I_GPM, I_GPOM, I_GPF, I_GPOF, I_WIN, I_WOUT, I_CONVW, I_CONVB, I_CLNG, I_CLNB,
       I_MU, I_W0, I_W2, I_A0, I_A2, I_G2, I_KK, I_KA, I_RK, I_LNG, I_LNB, I_RELB, I_WF1, I_WF2, N_IN };
constexpr size_t MiB = 1u << 20;
constexpr size_t WS_CTL = 0, WS_WIN = 1 * MiB, WS_WOUT = WS_WIN + 24 * MiB, WS_WF1 = WS_WOUT + 8 * MiB, WS_WF2 = WS_WF1 + 44 * MiB, WS_MOD = WS_WF2 + 22 * MiB,
    WS_SC = WS_MOD + 4 * MiB, WS_XN = WS_SC + 1 * MiB, WS_U = WS_XN + 34 * MiB, WS_MIX = WS_U + 98 * MiB, WS_T = WS_MIX + 34 * MiB, WS_H = WS_T + 66 * MiB,
    WS_Z = WS_H + 90 * MiB, WS_STR = WS_Z + 17 * MiB  , WS_YR = WS_STR + 7 * 17 * MiB, WS_OP = WS_YR + 17 * MiB  , WS_ML = WS_OP + 96 * MiB, WS_QI = WS_ML + 4 * MiB, WS_PT = WS_QI + 17 * MiB, WS_LT = WS_PT + 32 * MiB, WS_SSF = WS_LT + 32 * MiB, WS_BON = WS_SSF + 16 * MiB, WS_LORA = WS_BON + 1 * MiB, WS_END = WS_LORA + 1 * MiB;
constexpr size_t STR_STRIDE = 17 * MiB / 4;
enum { S_W = 0, S_KK, S_KA, S_KP, S_R, S_V, S_G };

typedef unsigned short bf16;
typedef float f32x4 __attribute__((ext_vector_type(4)));
typedef short bf16x8 __attribute__((ext_vector_type(8)));
typedef short s16x4 __attribute__((ext_vector_type(4)));
typedef unsigned u32x4 __attribute__((ext_vector_type(4)));
typedef unsigned u32x2 __attribute__((ext_vector_type(2)));
#define LAS __attribute__((address_space(3)))
__device__ __forceinline__ float bf2f(unsigned b) { return __uint_as_float(b << 16); }
__device__ __forceinline__ unsigned f2bf(float f) { unsigned u = __float_as_uint(f); return (u + 0x7fffu + ((u >> 16) & 1u)) >> 16; }
__device__ __forceinline__ unsigned pk2(float lo, float hi) { return f2bf(lo) | (f2bf(hi) << 16); }
__device__ __forceinline__ float sigmoid_f(float x) { return 1.0f / (1.0f + __expf(-x)); }
__device__ __forceinline__ float wave_sum(float v) {
#pragma unroll
    for (int o = 1; o < 64; o <<= 1) v += __shfl_xor(v, o);
    return v;
}

#define XB_TMO      128
#define XB_XCNT(j)  (256  + 64 * (j))
#define XB_XSUB(j)  (1280 + 64 * (j))
#define XB_XGEN(j)  (2304 + 64 * (j))
#define XB_TOP      3328
#define XB_TOPGEN   3392
#define XCD_BAR_WORDS 3456
#define XB_SPIN_CAP (1u << 18)

__device__ __forceinline__ unsigned xb_ld(unsigned* p)              { return __hip_atomic_load(p, __ATOMIC_RELAXED, __HIP_MEMORY_SCOPE_AGENT); }
__device__ __forceinline__ unsigned xb_add(unsigned* p, unsigned v) { return __hip_atomic_fetch_add(p, v, __ATOMIC_RELAXED, __HIP_MEMORY_SCOPE_AGENT); }
__device__ __forceinline__ unsigned xb_xcc_id() { return (unsigned)__builtin_amdgcn_s_getreg((3 << 11) | 20) & 0xFu; }
#define XB_SPIN(cond, bar) do { unsigned _sp = 0; while (cond) { __builtin_amdgcn_s_sleep(1); \
    if ((++_sp & 255u) == 0u) { if (xb_ld(&(bar)[XB_TMO])) break; if (_sp > XB_SPIN_CAP) { atomicAdd(&(bar)[XB_TMO], 1u); break; } } } } while (0)

struct XcdBarrier {
    unsigned* bar; unsigned x;
    volatile LAS unsigned* st;
};

__device__ __forceinline__ XcdBarrier xcd_barrier_post(unsigned* bar, volatile LAS unsigned* st) {
    XcdBarrier b; b.bar = bar; b.x = xb_xcc_id(); b.st = st;
    if (threadIdx.x == 0) (void)xb_add(&bar[XB_XCNT(b.x)], 1u);
    return b;
}
__device__ __forceinline__ void xcd_barrier_complete(unsigned* bar, unsigned x, unsigned& nloc, unsigned& nx) {
    const unsigned G = gridDim.x * gridDim.y * gridDim.z;
    unsigned sum, cnt, mine, sp = 0u;
    for (;;) {
        sum = 0u; cnt = 0u; mine = 0u;
#pragma unroll
        for (unsigned j = 0; j < 16; ++j) { const unsigned c = xb_ld(&bar[XB_XCNT(j)]); sum += c; cnt += (c > 0u) ? 1u : 0u; mine = (j == x) ? c : mine; }
        if (sum == G) break;
        __builtin_amdgcn_s_sleep(1);
        if ((++sp & 255u) == 0u) { if (xb_ld(&bar[XB_TMO])) break; if (sp > XB_SPIN_CAP) { atomicAdd(&bar[XB_TMO], 1u); break; } }
    }
    nloc = mine > 0u ? mine : 1u; nx = cnt > 0u ? cnt : 1u;
}

__device__ __forceinline__ void xcd_barrier(const XcdBarrier& b) {
    asm volatile("s_waitcnt vmcnt(0)" ::: "memory");
    __syncthreads();
    if (threadIdx.x == 0) {
        unsigned* bar = b.bar;
        __builtin_amdgcn_s_waitcnt(0);
        unsigned nloc = b.st[0], nx = b.st[1];
        if (nloc == 0u) { xcd_barrier_complete(bar, b.x, nloc, nx); b.st[0] = nloc; b.st[1] = nx; }
        const unsigned old = xb_add(&bar[XB_XSUB(b.x)], 1u);
        const unsigned gen = old / nloc;
        if (old + 1u == (gen + 1u) * nloc) {
            __builtin_amdgcn_fence(__ATOMIC_RELEASE, "agent");
            asm volatile("s_waitcnt vmcnt(0)" ::: "memory");
            const unsigned og = xb_add(&bar[XB_TOP], 1u);
            const unsigned tg = og / nx;
            if (og + 1u == (tg + 1u) * nx) xb_add(&bar[XB_TOPGEN], 1u);
            else XB_SPIN(xb_ld(&bar[XB_TOPGEN]) == tg, bar);
            __builtin_amdgcn_fence(__ATOMIC_ACQUIRE, "agent");
            xb_add(&bar[XB_XGEN(b.x)], 1u);
            asm volatile("s_waitcnt vmcnt(0)" ::: "memory");
        } else {
            XB_SPIN(xb_ld(&bar[XB_XGEN(b.x)]) == gen, bar);
            __builtin_amdgcn_fence(__ATOMIC_ACQUIRE, "agent");
            asm volatile("s_waitcnt vmcnt(0)" ::: "memory");
        }
    }
    __syncthreads();
}

struct P {
    const float* in[N_IN]; float* out; unsigned char* ws;
};
__device__ __forceinline__ bf16* wsb(const P& p, size_t off) { return (bf16*)(p.ws + off); }
__device__ __forceinline__ float* wsf(const P& p, size_t off) { return (float*)(p.ws + off); }
__device__ __forceinline__ const float* modv(const P& p, int l, int s, int j) { return wsf(p, WS_MOD) + ((size_t)(l * NSEQ + s) * 6 + j) * DM; }
__device__ __forceinline__ int seq_of_row(int row) { return row < MP ? (row >> 12) : NBP + ((row - MP) >> 2); }

__device__ __forceinline__ void transpose_item(const float* W, int K, int N, bf16* WT, int drow0, LAS float* scr, int k0, int n0, int lane) {
#pragma unroll 8
    for (int i = 0; i < 32; ++i) { const int kk = 2 * i + (lane >> 5); scr[kk * 33 + (lane & 31)] = W[(size_t)(k0 + kk) * N + n0 + (lane & 31)]; }
    asm volatile("s_waitcnt lgkmcnt(0)" ::: "memory");
    const int c = lane & 7;
#pragma unroll
    for (int j = 0; j < 4; ++j) { const int n = (lane >> 3) + 8 * j; const LAS float* s = scr + (8 * c) * 33 + n;
        u32x4 o; o.x = pk2(s[0 * 33], s[1 * 33]); o.y = pk2(s[2 * 33], s[3 * 33]); o.z = pk2(s[4 * 33], s[5 * 33]); o.w = pk2(s[6 * 33], s[7 * 33]);
        *(u32x4*)(WT + (size_t)(drow0 + n) * K + k0 + 8 * c) = o; }
    asm volatile("s_waitcnt lgkmcnt(0)" ::: "memory");
}
__device__ __forceinline__ void ph_transpose(const P& p, LAS unsigned char* lds) {
    const int tid = TIDX, lane = tid & 63, wave = __builtin_amdgcn_readfirstlane(tid >> 6);
    LAS float* scr = (LAS float*)(lds + wave * 8704);
    const int gw = BIDX * NWAVES + wave, NGW = GDIM * NWAVES;
    constexpr int I_A = 16 * (INC / 32), I_B = 16 * (DM / 32), I_C = 16 * (FF2 / 32), I_D = (FF / 64) * (DM / 32), I_L = I_A + I_B + I_C + I_D;
    for (int it = gw; it < NL * I_L; it += NGW) {
        const int l = it / I_L; int r = it % I_L;
        if (r < I_A) { const int nb = INC / 32, kb = r / nb, n0 = 32 * (r % nb); transpose_item(p.in[I_WIN] + (size_t)l * DM * INC, DM, INC, wsb(p, WS_WIN) + (size_t)l * INC * DM, n0, scr, 64 * kb, n0, lane); continue; } r -= I_A;
        if (r < I_B) { const int nb = DM / 32, kb = r / nb, n0 = 32 * (r % nb); transpose_item(p.in[I_WOUT] + (size_t)l * DM * DM, DM, DM, wsb(p, WS_WOUT) + (size_t)l * DM * DM, n0, scr, 64 * kb, n0, lane); continue; } r -= I_B;
        if (r < I_C) { const int nb = FF2 / 32, kb = r / nb, n0 = 32 * (r % nb);
            const int f = n0 < FF ? n0 : n0 - FF; const int drow0 = (f / 128) * 256 + (n0 < FF ? 0 : 128) + (f % 128);
            transpose_item(p.in[I_WF1] + (size_t)l * DM * FF2, DM, FF2, wsb(p, WS_WF1) + (size_t)l * FF2 * DM, drow0, scr, 64 * kb, n0, lane); continue; } r -= I_C;
        { const int nb = DM / 32, kb = r / nb, n0 = 32 * (r % nb); transpose_item(p.in[I_WF2] + (size_t)l * FF * DM, FF, DM, wsb(p, WS_WF2) + (size_t)l * DM * FF, n0, scr, 64 * kb, n0, lane); }
    }
}
__device__ __forceinline__ void ph_silu(const P& p) {
    for (int i = BIDX * NTHR + TIDX; i < NSEQ * DM; i += GDIM * NTHR) { const int s = i / DM, k = i % DM; const float c = s < NBP ? p.in[I_CP][s * DM + k] : p.in[I_CS][(s - NBP) * DM + k]; wsf(p, WS_SC)[i] = c * sigmoid_f(c); }
}
__device__ __forceinline__ void ph_mod(const P& p, LAS unsigned char* lds) {
    LAS float* red = (LAS float*)lds;
    const int tid = TIDX, lane = tid & 63, wave = __builtin_amdgcn_readfirstlane(tid >> 6);
    const float* SC = wsf(p, WS_SC);
    for (int it = BIDX; it < NL * 96; it += GDIM) {
        const int l = it / 96, col = (it % 96) * 64 + lane;
        float acc[NSEQ];
#pragma unroll
        for (int s = 0; s < NSEQ; ++s) acc[s] = 0.f;
        const float* W = p.in[I_WADA] + (size_t)l * DM * 6144 + col;
        for (int k = wave * 128; k < wave * 128 + 128; ++k) { const float w = W[(size_t)k * 6144];
#pragma unroll
            for (int s = 0; s < NSEQ; ++s) acc[s] += SC[s * DM + k] * w; }
#pragma unroll
        for (int s = 0; s < NSEQ; ++s) red[(wave * NSEQ + s) * 64 + lane] = acc[s];
        __syncthreads();
        for (int e = tid; e < NSEQ * 64; e += NTHR) { const int s = e >> 6, c = e & 63; float v = 0.f;
#pragma unroll
            for (int w = 0; w < 8; ++w) v += red[(w * NSEQ + s) * 64 + c];
            const int cc = (it % 96) * 64 + c; wsf(p, WS_MOD)[(size_t)(l * NSEQ + s) * 6144 + cc] = v + p.in[I_BADA][l * 6144 + cc]; }
        __syncthreads();
    }
}
__device__ __forceinline__ void norm_row_bf16(const float* xrow, const float* g, const float* scale, const float* shift, bf16* orow, int lane) {
    const f32x4* xr = (const f32x4*)xrow + lane; f32x4 v[4]; float s = 0.f;
#pragma unroll
    for (int j = 0; j < 4; ++j) { v[j] = xr[64 * j]; s += (v[j].x * v[j].x + v[j].y * v[j].y) + (v[j].z * v[j].z + v[j].w * v[j].w); }
    const float rstd = 1.0f / sqrtf(wave_sum(s) * (1.0f / DM) + 1e-6f);
#pragma unroll
    for (int j = 0; j < 4; ++j) { const int c = 4 * lane + 256 * j; const f32x4 gg = *(const f32x4*)(g + c), sc = *(const f32x4*)(scale + c), sh = *(const f32x4*)(shift + c);
        f32x4 o; o.x = v[j].x * rstd * gg.x * (1.f + sc.x) + sh.x; o.y = v[j].y * rstd * gg.y * (1.f + sc.y) + sh.y; o.z = v[j].z * rstd * gg.z * (1.f + sc.z) + sh.z; o.w = v[j].w * rstd * gg.w * (1.f + sc.w) + sh.w;
        u32x2 w; w.x = pk2(o.x, o.y); w.y = pk2(o.z, o.w); *(u32x2*)(orow + c) = w; }
}
__device__ __forceinline__ void ph_norm0(const P& p) {
    const int lane = TIDX & 63, gw = BIDX * NWAVES + __builtin_amdgcn_readfirstlane(TIDX >> 6), NGW = GDIM * NWAVES;
    for (int row = gw; row < MR; row += NGW) { const int s = seq_of_row(row);
        const float* x = row < MP ? p.in[I_XP] + (size_t)row * DM : p.in[I_XS] + (size_t)(row - MP) * DM;
        norm_row_bf16(x, p.in[I_GPM], modv(p, 0, s, 1), modv(p, 0, s, 0), wsb(p, WS_XN) + (size_t)row * DM, lane); }
}
__device__ __forceinline__ void ph_resid(const P& p, int l, const int which) {
    const int lane = TIDX & 63, gw = BIDX * NWAVES + __builtin_amdgcn_readfirstlane(TIDX >> 6), NGW = GDIM * NWAVES;
    for (int row = gw; row < MR; row += NGW) { const int s = seq_of_row(row);
        const float* xin = (l == 0 && which == 0) ? (row < MP ? p.in[I_XP] + (size_t)row * DM : p.in[I_XS] + (size_t)(row - MP) * DM) : p.out + (size_t)row * DM;
        float* xout = p.out + (size_t)row * DM;
        const float* t = wsf(p, WS_T) + (size_t)row * DM;
        const float* gpost = p.in[which == 0 ? I_GPOM : I_GPOF] + l * DM; const float* gate = modv(p, l, s, which == 0 ? 2 : 5);
        f32x4 tv[4], xv[4]; float ss = 0.f;
#pragma unroll
        for (int j = 0; j < 4; ++j) { tv[j] = ((const f32x4*)t)[lane + 64 * j]; xv[j] = ((const f32x4*)xin)[lane + 64 * j]; ss += (tv[j].x * tv[j].x + tv[j].y * tv[j].y) + (tv[j].z * tv[j].z + tv[j].w * tv[j].w); }
        const float rstd = 1.0f / sqrtf(wave_sum(ss) * (1.0f / DM) + 1e-6f); float s2 = 0.f;
#pragma unroll
        for (int j = 0; j < 4; ++j) { const int c = 4 * lane + 256 * j; const f32x4 gp = *(const f32x4*)(gpost + c), ga = *(const f32x4*)(gate + c);
            xv[j].x += ga.x * (tv[j].x * rstd * gp.x); xv[j].y += ga.y * (tv[j].y * rstd * gp.y); xv[j].z += ga.z * (tv[j].z * rstd * gp.z); xv[j].w += ga.w * (tv[j].w * rstd * gp.w);
            ((f32x4*)xout)[lane + 64 * j] = xv[j]; s2 += (xv[j].x * xv[j].x + xv[j].y * xv[j].y) + (xv[j].z * xv[j].z + xv[j].w * xv[j].w); }
        if (which == 1 && l == NL - 1) continue;
        const int ln = which == 0 ? l : l + 1;
        const float* gn = p.in[which == 0 ? I_GPF : I_GPM] + ln * DM; const float* sc = modv(p, ln, s, which == 0 ? 4 : 1); const float* sh = modv(p, ln, s, which == 0 ? 3 : 0);
        const float rstd2 = 1.0f / sqrtf(wave_sum(s2) * (1.0f / DM) + 1e-6f); bf16* orow = wsb(p, WS_XN) + (size_t)row * DM;
#pragma unroll
        for (int j = 0; j < 4; ++j) { const int c = 4 * lane + 256 * j; const f32x4 gg = *(const f32x4*)(gn + c), s_ = *(const f32x4*)(sc + c), h_ = *(const f32x4*)(sh + c);
            u32x2 w; w.x = pk2(xv[j].x * rstd2 * gg.x * (1.f + s_.x) + h_.x, xv[j].y * rstd2 * gg.y * (1.f + s_.y) + h_.y); w.y = pk2(xv[j].z * rstd2 * gg.z * (1.f + s_.z) + h_.z, xv[j].w * rstd2 * gg.w * (1.f + s_.w) + h_.w);
            *(u32x2*)(orow + c) = w; }
    }
}

template <int WHICH> __device__ __forceinline__ void ph_gemm(const P& p, int l, LAS unsigned char* lds) {
    pg8::StaticOrder S;
    if constexpr (WHICH == 0) { pg8::Gemm g{wsb(p, WS_XN), wsb(p, WS_WIN) + (size_t)l * INC * DM, MPAD, INC, DM}; S.init(MPAD, INC, GDIM, BIDX);
        pg8::EpiBf16 E{wsb(p, WS_U), INC}; pg8::gemm_phase<pg8::EpiBf16, pg8::StaticOrder, true, true>(lds, g, S, E); }
    if constexpr (WHICH == 1) { pg8::Gemm g{wsb(p, WS_MIX), wsb(p, WS_WOUT) + (size_t)l * DM * DM, MPAD, DM, DM}; S.init(MPAD, DM, GDIM, BIDX);
        pg8::EpiF32 E{wsf(p, WS_T), DM}; pg8::gemm_phase<pg8::EpiF32, pg8::StaticOrder, true, true>(lds, g, S, E); }
    if constexpr (WHICH == 2) { pg8::Gemm g{wsb(p, WS_XN), wsb(p, WS_WF1) + (size_t)l * FF2 * DM, MPAD, FF2, DM}; S.init(MPAD, FF2, GDIM, BIDX);
        pg8::EpiSwiGLU E{wsb(p, WS_H), FF}; pg8::gemm_phase<pg8::EpiSwiGLU, pg8::StaticOrder, true, true>(lds, g, S, E); }
    if constexpr (WHICH == 3) { pg8::Gemm g{wsb(p, WS_H), wsb(p, WS_WF2) + (size_t)l * DM * FF, MPAD, DM, FF}; S.init(MPAD, DM, GDIM, BIDX);
        pg8::EpiF32 E{wsf(p, WS_T), DM}; pg8::gemm_phase<pg8::EpiF32, pg8::StaticOrder, true, true>(lds, g, S, E); }
}

__device__ __forceinline__ void ph_glu(const P& p, int l) {
    const bf16* U = wsb(p, WS_U); float* Z = wsf(p, WS_Z);
    const int gt = BIDX * NTHR + TIDX, NT = GDIM * NTHR;
    for (int idx = gt; idx < MR * 64; idx += NT) { const int row = idx >> 6, c4 = (idx & 63) * 4;
        const u32x2 a = *(const u32x2*)(U + (size_t)row * INC + UC_CA + c4), g = *(const u32x2*)(U + (size_t)row * INC + UC_CG + c4);
        f32x4 z; z.x = bf2f(a.x & 0xffffu) * sigmoid_f(bf2f(g.x & 0xffffu)); z.y = bf2f(a.x >> 16) * sigmoid_f(bf2f(g.x >> 16)); z.z = bf2f(a.y & 0xffffu) * sigmoid_f(bf2f(g.y & 0xffffu)); z.w = bf2f(a.y >> 16) * sigmoid_f(bf2f(g.y >> 16));
        *(f32x4*)(Z + (size_t)row * 256 + c4) = z;
        if (row < MP) { const int n = row >> 12, t = row & 4095; if (t >= TP - 30) *(f32x4*)(p.out + O_CONVP + ((size_t)(l * NBP + n) * 30 + (t - (TP - 30))) * 256 + c4) = z; }
        else { const int rs = row - MP, n = rs >> 2, s = rs & 3; *(f32x4*)(p.out + O_CONVS + ((size_t)(l * NBS + n) * 30 + 26 + s) * 256 + c4) = z; }
    }
    for (int idx = gt; idx < NBS * 26 * 64; idx += NT) { const int n = idx / (26 * 64), r = idx % (26 * 64), i = r >> 6, c4 = (r & 63) * 4;
        *(f32x4*)(p.out + O_CONVS + ((size_t)(l * NBS + n) * 30 + i) * 256 + c4) = *(const f32x4*)(p.in[I_CCONV] + ((size_t)(l * NBS + n) * 30 + i + 4) * 256 + c4); }
}
__device__ __forceinline__ void ph_conv(const P& p, int l, LAS unsigned char* lds, const int b0, const int nb) {
    LAS float (*red)[2][4] = (LAS float (*)[2][4])lds;
    const int tid = TIDX, c = tid & 255, half = tid >> 8, wv = (tid >> 6) & 3, lane = tid & 63;
    const float* Z = wsf(p, WS_Z); const float* cw = p.in[I_CONVW] + (size_t)l * CKW * 256 + c;
    float w[CKW];
#pragma unroll
    for (int j = 0; j < CKW; ++j) w[j] = cw[j * 256];
    const float cb = p.in[I_CONVB][l * 256 + c], lg = p.in[I_CLNG][l * 256 + c], lb = p.in[I_CLNB][l * 256 + c];
    for (int pr = b0; pr < MR / 2; pr += nb) { const int row = 2 * pr + half; float acc = cb;
        if (row < MP) { const int t = row & 4095;
#pragma unroll
            for (int j = 0; j < CKW; ++j) { const int tau = t + j - 30; if (tau >= 0) acc += w[j] * Z[(size_t)(row + j - 30) * 256 + c]; } }
        else { const int rs = row - MP, n = rs >> 2, s = rs & 3;
#pragma unroll
            for (int j = 0; j < CKW; ++j) { const int tau = s + j - 30; const float z = tau >= 0 ? Z[(size_t)(MP + n * 4 + tau) * 256 + c] : p.in[I_CCONV][((size_t)(l * NBS + n) * 30 + 30 + tau) * 256 + c]; acc += w[j] * z; } }
        float s1 = wave_sum(acc); if (lane == 0) red[0][half][wv] = s1; __syncthreads();
        const float mean = (red[0][half][0] + red[0][half][1] + red[0][half][2] + red[0][half][3]) * (1.f / 256.f); const float d = acc - mean;
        float s2 = wave_sum(d * d); if (lane == 0) red[1][half][wv] = s2; __syncthreads();
        const float var = (red[1][half][0] + red[1][half][1] + red[1][half][2] + red[1][half][3]) * (1.f / 256.f);
        const float y = d * (1.0f / sqrtf(var + 1e-5f)) * lg + lb;
        wsb(p, WS_MIX)[(size_t)row * DM + c] = (bf16)f2bf(y * sigmoid_f(y));
        __syncthreads();
    }
}
__device__ __forceinline__ void ph_rwkv_prep(const P& p, int l, LAS unsigned char* lds) {
    LAS float* xs = (LAS float*)lds;
    const int tid = TIDX, c = tid & 255, half = tid >> 8;
    const bf16* U = wsb(p, WS_U); const float* mu = p.in[I_MU] + l * 1024; float* STR = wsf(p, WS_STR);
    for (int grp = MP / 16 + BIDX; grp < MR / 16; grp += GDIM) {
        for (int i = 0; i < 32; ++i) { const int e = tid + NTHR * i, tok = e >> 10, col = e & 1023, row = grp * 16 + tok;
            const float u = bf2f(U[(size_t)row * INC + UC_R + col]); float pv;
            if (row < MP) pv = (row & 4095) == 0 ? 0.f : bf2f(U[(size_t)(row - 1) * INC + UC_R + col]);
            else { const int rs = row - MP; pv = (rs & 3) == 0 ? p.in[I_SSHIFT][(size_t)(l * NBS + (rs >> 2)) * 1024 + col] : bf2f(U[(size_t)(row - 1) * INC + UC_R + col]); }
            float x = u + (pv - u) * mu[col];
            if (col >= 768 && col < 832) x = tanhf(x); else if (col >= 896) x = sigmoid_f(x);
            xs[e] = x; }
        __syncthreads();
        float aw[8], aa[8], ag[8];
#pragma unroll
        for (int t = 0; t < 8; ++t) { aw[t] = 0.f; aa[t] = 0.f; ag[t] = 0.f; }
        const float* w2 = p.in[I_W2] + (size_t)l * 64 * 256 + c; const float* a2 = p.in[I_A2] + (size_t)l * 64 * 256 + c; const float* g2 = p.in[I_G2] + (size_t)l * 128 * 256 + c;
        for (int k = 0; k < 64; ++k) { const float wv = w2[k * 256], av = a2[k * 256];
#pragma unroll
            for (int t = 0; t < 8; ++t) { aw[t] += xs[(half * 8 + t) * 1024 + 768 + k] * wv; aa[t] += xs[(half * 8 + t) * 1024 + 832 + k] * av; } }
        for (int k = 0; k < 128; ++k) { const float gv = g2[k * 256];
#pragma unroll
            for (int t = 0; t < 8; ++t) ag[t] += xs[(half * 8 + t) * 1024 + 896 + k] * gv; }
        const float w0 = p.in[I_W0][l * 256 + c], a0 = p.in[I_A0][l * 256 + c], kkw = p.in[I_KK][l * 256 + c], kaw = p.in[I_KA][l * 256 + c];
#pragma unroll
        for (int t = 0; t < 8; ++t) { const int tok = half * 8 + t, row = grp * 16 + tok;
            const float r = xs[tok * 1024 + c], k = xs[tok * 1024 + 256 + c], v = xs[tok * 1024 + 512 + c];
            const float wlog = -0.6065306597126334f * sigmoid_f(w0 + aw[t]); const float a = sigmoid_f(a0 + aa[t]);
            float kk = k * kkw; const float nrm = sqrtf(wave_sum(kk * kk)); kk = kk / fmaxf(nrm, 1e-12f);
            const float kp = k * (1.0f + (a - 1.0f) * kaw);
            const size_t o = (size_t)row * 256 + c;
            STR[S_W * STR_STRIDE + o] = __expf(wlog); STR[S_KK * STR_STRIDE + o] = kk; STR[S_KA * STR_STRIDE + o] = kk * a; STR[S_KP * STR_STRIDE + o] = kp;
            STR[S_R * STR_STRIDE + o] = r; STR[S_V * STR_STRIDE + o] = v; STR[S_G * STR_STRIDE + o] = ag[t]; }
        __syncthreads();
    }
}
__device__ __forceinline__ void ph_rwkv_scan(const P& p, int l, LAS unsigned char* lds, const int unit) {
    LAS float (*st)[8][64] = (LAS float (*)[8][64])lds;
    const int seq = unit >> 2, h = unit & 3, lane = TIDX & 63;
    const float* STR = wsf(p, WS_STR); float* YR = wsf(p, WS_YR);
    const int row0 = seq < NBP ? seq * TP : MP + (seq - NBP) * TS, nsteps = seq < NBP ? TP : TS;
    float S[64];
    if (seq < NBP) {
#pragma unroll
        for (int k = 0; k < 64; ++k) S[k] = 0.f;
    } else { const float* s0 = p.in[I_SWKV] + ((size_t)((l * NBS + (seq - NBP)) * 4 + h) * 64 + lane) * 64;
#pragma unroll
        for (int k = 0; k < 64; ++k) S[k] = s0[k]; }
    for (int t0 = 0; t0 < nsteps; t0 += 8) {
        float vv[8];
#pragma unroll
        for (int i = 0; i < 8; ++i) { const bool ok = t0 + i < nsteps; const size_t o = (size_t)(row0 + (ok ? t0 + i : 0)) * 256 + h * 64 + lane;
            st[0][i][lane] = STR[S_W * STR_STRIDE + o]; st[1][i][lane] = STR[S_KK * STR_STRIDE + o]; st[2][i][lane] = STR[S_KA * STR_STRIDE + o];
            st[3][i][lane] = STR[S_KP * STR_STRIDE + o]; st[4][i][lane] = STR[S_R * STR_STRIDE + o]; vv[i] = STR[S_V * STR_STRIDE + o]; }
        asm volatile("s_waitcnt vmcnt(0) lgkmcnt(0)" ::: "memory");
#pragma unroll
        for (int i = 0; i < 8; ++i) { if (t0 + i < nsteps) {
            float d0 = 0.f, d1 = 0.f;
#pragma unroll
            for (int k = 0; k < 64; k += 4) { const f32x4 q = *(const LAS f32x4*)&st[1][i][k]; d0 += S[k] * q.x; d1 += S[k + 1] * q.y; d0 += S[k + 2] * q.z; d1 += S[k + 3] * q.w; }
            const float d = d0 + d1, v = vv[i]; float y0 = 0.f, y1 = 0.f;
#pragma unroll
            for (int k = 0; k < 64; k += 4) { const f32x4 w = *(const LAS f32x4*)&st[0][i][k], ka = *(const LAS f32x4*)&st[2][i][k], kp = *(const LAS f32x4*)&st[3][i][k], r = *(const LAS f32x4*)&st[4][i][k];
                S[k] = S[k] * w.x - d * ka.x + v * kp.x; S[k + 1] = S[k + 1] * w.y - d * ka.y + v * kp.y; S[k + 2] = S[k + 2] * w.z - d * ka.z + v * kp.z; S[k + 3] = S[k + 3] * w.w - d * ka.w + v * kp.w;
                y0 += S[k] * r.x; y1 += S[k + 1] * r.y; y0 += S[k + 2] * r.z; y1 += S[k + 3] * r.w; }
            YR[(size_t)(row0 + t0 + i) * 256 + h * 64 + lane] = y0 + y1; } }
        asm volatile("s_waitcnt lgkmcnt(0)" ::: "memory");
    }
    float* so = p.out + (seq < NBP ? O_WKVP + ((size_t)((l * NBP + seq) * 4 + h) * 64 + lane) * 64 : O_WKVS + ((size_t)((l * NBS + (seq - NBP)) * 4 + h) * 64 + lane) * 64);
#pragma unroll
    for (int k = 0; k < 64; k += 4) *(f32x4*)(so + k) = (f32x4){S[k], S[k + 1], S[k + 2], S[k + 3]};
}
__device__ __forceinline__ void ph_rwkv_post(const P& p, int l) {
    const int lane = TIDX & 63, gw = BIDX * NWAVES + __builtin_amdgcn_readfirstlane(TIDX >> 6), NGW = GDIM * NWAVES;
    const float* STR = wsf(p, WS_STR); const float* YR = wsf(p, WS_YR);
    for (int u = MP * 4 + gw; u < MR * 4; u += NGW) { const int row = u >> 2, h = u & 3, c = h * 64 + lane; const size_t o = (size_t)row * 256 + c;
        const float y = YR[o], mean = wave_sum(y) * (1.f / 64.f), d = y - mean, var = wave_sum(d * d) * (1.f / 64.f);
        const float yn = d * (1.0f / sqrtf(var + 64e-5f)) * p.in[I_LNG][l * 256 + c] + p.in[I_LNB][l * 256 + c];
        const float bon = wave_sum(STR[S_R * STR_STRIDE + o] * STR[S_KP * STR_STRIDE + o] * p.in[I_RK][l * 256 + c]) * STR[S_V * STR_STRIDE + o];
        wsb(p, WS_MIX)[(size_t)row * DM + 256 + c] = (bf16)f2bf((yn + bon) * STR[S_G * STR_STRIDE + o]); }
}
__device__ __forceinline__ void ph_copy_out(const P& p, int l) {
    const bf16* U = wsb(p, WS_U); const int gt = BIDX * NTHR + TIDX, NT = GDIM * NTHR;
    for (int idx = gt; idx < NBP * WINB * 256; idx += NT) { const int c4 = (idx & 255) * 4, i = (idx >> 8) & 2047, n = idx >> 19;
        const int isv = c4 >= 512, cc = c4 & 511; const u32x2 a = *(const u32x2*)(U + (size_t)(n * TP + (TP - WINB) + i) * INC + (isv ? UC_AV : UC_AK) + cc);
        *(f32x4*)(p.out + (isv ? O_VP : O_KP) + ((size_t)(l * NBP + n) * WINB + i) * 512 + cc) = (f32x4){bf2f(a.x & 0xffffu), bf2f(a.x >> 16), bf2f(a.y & 0xffffu), bf2f(a.y >> 16)}; }
    for (int idx = gt; idx < MS * 256; idx += NT) { const int c4 = (idx & 255) * 4, rs = idx >> 8; const int isv = c4 >= 512, cc = c4 & 511;
        const u32x2 a = *(const u32x2*)(U + (size_t)(MP + rs) * INC + (isv ? UC_AV : UC_AK) + cc);
        *(f32x4*)(p.out + (isv ? O_VS : O_KS) + ((size_t)l * MS + rs) * 512 + cc) = (f32x4){bf2f(a.x & 0xffffu), bf2f(a.x >> 16), bf2f(a.y & 0xffffu), bf2f(a.y >> 16)}; }
    for (int idx = gt; idx < NSEQ * 256; idx += NT) { const int c4 = (idx & 255) * 4, s = idx >> 8; const int row = s < NBP ? s * TP + TP - 1 : MP + (s - NBP) * TS + TS - 1;
        const u32x2 a = *(const u32x2*)(U + (size_t)row * INC + UC_R + c4);
        float* o = s < NBP ? p.out + O_SHP + (size_t)(l * NBP + s) * 1024 + c4 : p.out + O_SHS + (size_t)(l * NBS + (s - NBP)) * 1024 + c4;
        *(f32x4*)o = (f32x4){bf2f(a.x & 0xffffu), bf2f(a.x >> 16), bf2f(a.y & 0xffffu), bf2f(a.y >> 16)}; }
}
__device__ __forceinline__ int rel_bucket(int dist) {
    if (dist < 16) return dist;
    const float d = (float)dist; int lg = 16 + (int)(logf(d / 16.0f) / logf(128.0f) * 16.0f); return lg < 31 ? lg : 31;
}
__device__ __forceinline__ void ph_attn_p(const P& p, LAS unsigned char* lds, const int b0, const int nb) {
    LAS float* btab = (LAS float*)lds;
    constexpr int VROW = 144, VB = 32 * VROW;
    const int tid = TIDX, lane = tid & 63, wave = __builtin_amdgcn_readfirstlane(tid >> 6), fr = lane & 15, g = lane >> 4;
    LAS unsigned char* vst = lds + 3 * 129 * 8 * 4 + wave * VB;
    for (int e = tid; e < 3 * 129; e += NTHR) { const int br = e / 129, dl = e % 129, dil = br == 0 ? 1 : (br == 1 ? 4 : 16); const int b = rel_bucket(dl * dil);
        for (int h = 0; h < 8; ++h) btab[e * 8 + h] = p.in[I_RELB][b * 8 + h]; }
    __syncthreads();
    const bf16* U = wsb(p, WS_U); float* OP = wsf(p, WS_OP); float* ML = wsf(p, WS_ML);
    const int gw = b0 * NWAVES + wave, NGW = nb * NWAVES;
    for (int u = gw; u < 3 * NBP * 8 * 256; u += NGW) {
        const int br = u / 8192, rem = u % 8192, n = rem / 2048, h = (rem % 2048) / 256, rq = rem % 256;
        const int dil = br == 0 ? 1 : (br == 1 ? 4 : 16), tpr = 256 / dil, r = rq / tpr, qt = rq % tpr, j0 = 16 * qt, L = TP / dil;
        const size_t rowb = (size_t)n * TP;
        bf16x8 qf[2];
        { const bf16* qp = U + (rowb + (size_t)(j0 + fr) * dil + r) * INC + UC_AQ + h * 64 + 8 * g; qf[0] = *(const bf16x8*)qp; qf[1] = *(const bf16x8*)(qp + 32); }
        float sc[9][4]; float mx = -1e30f;
#pragma unroll
        for (int kt = 0; kt < 9; ++kt) {
            int kj = j0 - 128 + 16 * kt + fr; kj = kj < 0 ? 0 : kj;
            const bf16* kp = U + (rowb + (size_t)kj * dil + r) * INC + UC_AK + h * 64 + 8 * g;
            const bf16x8 k0 = *(const bf16x8*)kp, k1 = *(const bf16x8*)(kp + 32);
            f32x4 acc = {0.f, 0.f, 0.f, 0.f};
            acc = __builtin_amdgcn_mfma_f32_16x16x32_bf16(k0, qf[0], acc, 0, 0, 0);
            acc = __builtin_amdgcn_mfma_f32_16x16x32_bf16(k1, qf[1], acc, 0, 0, 0);
#pragma unroll
            for (int rg = 0; rg < 4; ++rg) { const int kjr = j0 - 128 + 16 * kt + 4 * g + rg, dl = j0 + fr - kjr; const bool ok = dl >= 0 && dl <= 128 && kjr >= 0;
                const float s = ok ? acc[rg] * 0.125f + btab[(br * 129 + (ok ? dl : 0)) * 8 + h] : -1e30f; sc[kt][rg] = s; mx = fmaxf(mx, s); }
        }
        mx = fmaxf(mx, __shfl_xor(mx, 16)); mx = fmaxf(mx, __shfl_xor(mx, 32));
        float lsum = 0.f;
#pragma unroll
        for (int kt = 0; kt < 9; ++kt)
#pragma unroll
            for (int rg = 0; rg < 4; ++rg) { const float e = __expf(sc[kt][rg] - mx); sc[kt][rg] = e; lsum += e; }
        lsum += __shfl_xor(lsum, 16); lsum += __shfl_xor(lsum, 32);
        f32x4 o[4];
#pragma unroll
        for (int dt = 0; dt < 4; ++dt) o[dt] = (f32x4){0.f, 0.f, 0.f, 0.f};
#pragma unroll
        for (int ks = 0; ks < 5; ++ks) {
#pragma unroll
            for (int i4 = 0; i4 < 4; ++i4) { const int ri = (lane >> 3) + 8 * i4; int kj = j0 - 128 + 32 * ks + ri; kj = kj < 0 ? 0 : (kj > L - 1 ? L - 1 : kj);
                const u32x4 v = *(const u32x4*)(U + (rowb + (size_t)kj * dil + r) * INC + UC_AV + h * 64 + (lane & 7) * 8);
                *(LAS u32x4*)(vst + ri * VROW + (lane & 7) * 16) = v; }
            asm volatile("s_waitcnt lgkmcnt(0)" ::: "memory");
            bf16x8 pf;
            { const unsigned a0 = pk2(sc[2 * ks][0], sc[2 * ks][1]), a1 = pk2(sc[2 * ks][2], sc[2 * ks][3]);
              unsigned a2 = 0u, a3 = 0u; if (ks < 4) { a2 = pk2(sc[2 * ks + 1 < 9 ? 2 * ks + 1 : 8][0], sc[2 * ks + 1 < 9 ? 2 * ks + 1 : 8][1]); a3 = pk2(sc[2 * ks + 1 < 9 ? 2 * ks + 1 : 8][2], sc[2 * ks + 1 < 9 ? 2 * ks + 1 : 8][3]); }
              const u32x4 t = {a0, a1, a2, a3}; pf = __builtin_bit_cast(bf16x8, t); }
#pragma unroll
            for (int dt = 0; dt < 4; ++dt) {
                LAS unsigned char* a = vst + (4 * g + (fr >> 2)) * VROW + (16 * dt + 4 * (fr & 3)) * 2;
                const s16x4 lo = __builtin_bit_cast(s16x4, __builtin_amdgcn_ds_read_tr16_b64_v4i16((LAS s16x4*)a));
                const s16x4 hi = __builtin_bit_cast(s16x4, __builtin_amdgcn_ds_read_tr16_b64_v4i16((LAS s16x4*)(a + 16 * VROW)));
                const bf16x8 vf = {lo[0], lo[1], lo[2], lo[3], hi[0], hi[1], hi[2], hi[3]};
                o[dt] = __builtin_amdgcn_mfma_f32_16x16x32_bf16(pf, vf, o[dt], 0, 0, 0); }
            asm volatile("s_waitcnt lgkmcnt(0)" ::: "memory");
        }
#pragma unroll
        for (int rg = 0; rg < 4; ++rg) { const size_t row = rowb + (size_t)(j0 + 4 * g + rg) * dil + r;
#pragma unroll
            for (int dt = 0; dt < 4; ++dt) OP[((size_t)br * MP + row) * 512 + h * 64 + 16 * dt + fr] = o[dt][rg]; }
        if (g == 0) { const size_t row = rowb + (size_t)(j0 + fr) * dil + r; float* ml = ML + (((size_t)br * MP + row) * 8 + h) * 2; ml[0] = mx; ml[1] = lsum; }
    }
}
__device__ __forceinline__ void ph_attn_merge(const P& p, const int b0, const int nb) {
    const float* OP = wsf(p, WS_OP); const float* ML = wsf(p, WS_ML); const int gt = b0 * NTHR + TIDX, NT = nb * NTHR;
    for (int idx = gt; idx < MP * 128; idx += NT) { const int row = idx >> 7, c4 = (idx & 127) * 4, h = c4 >> 6;
        float m[3], l[3]; float M = -1e30f;
#pragma unroll
        for (int b = 0; b < 3; ++b) { m[b] = ML[(((size_t)b * MP + row) * 8 + h) * 2]; l[b] = ML[(((size_t)b * MP + row) * 8 + h) * 2 + 1]; M = fmaxf(M, m[b]); }
        f32x4 num = {0.f, 0.f, 0.f, 0.f}; float den = 0.f;
#pragma unroll
        for (int b = 0; b < 3; ++b) { const float w = __expf(m[b] - M); den += w * l[b]; num += *(const f32x4*)(OP + ((size_t)b * MP + row) * 512 + c4) * w; }
        const float inv = 1.0f / den; u32x2 w; w.x = pk2(num.x * inv, num.y * inv); w.y = pk2(num.z * inv, num.w * inv);
        *(u32x2*)(wsb(p, WS_MIX) + (size_t)row * DM + 512 + c4) = w; }
}
__device__ __forceinline__ void ph_attn_s(const P& p, int l, const int b0, const int nb) {
    const int lane = TIDX & 63, sub = lane & 15, ks = lane >> 4, gw = b0 * NWAVES + __builtin_amdgcn_readfirstlane(TIDX >> 6), NGW = nb * NWAVES;
    const bf16* U = wsb(p, WS_U);
    for (int u = gw; u < NBS * TS * 8; u += NGW) { const int h = u & 7, s = (u >> 3) & 3, n = u >> 5; const int row = MP + n * TS + s;
        f32x4 q; { const u32x2 a = *(const u32x2*)(U + (size_t)row * INC + UC_AQ + h * 64 + 4 * sub); q = (f32x4){bf2f(a.x & 0xffffu), bf2f(a.x >> 16), bf2f(a.y & 0xffffu), bf2f(a.y >> 16)}; }
        float mr = -1e30f, lr = 0.f; f32x4 o = {0.f, 0.f, 0.f, 0.f};
#pragma unroll 1
        for (int br = 0; br < 3; ++br) { const int dil = br == 0 ? 1 : (br == 1 ? 4 : 16);
#pragma unroll 1
            for (int it = 0; it < 33; ++it) { const int m = 4 * it + ks; const bool ok = m <= 128; const int idx = WINB + s - (ok ? m : 0) * dil;
                f32x4 kv, vv;
                if (idx >= WINB) { const size_t ro = (size_t)(MP + n * TS + (idx - WINB)) * INC + h * 64 + 4 * sub; const u32x2 a = *(const u32x2*)(U + ro + UC_AK), b = *(const u32x2*)(U + ro + UC_AV);
                    kv = (f32x4){bf2f(a.x & 0xffffu), bf2f(a.x >> 16), bf2f(a.y & 0xffffu), bf2f(a.y >> 16)}; vv = (f32x4){bf2f(b.x & 0xffffu), bf2f(b.x >> 16), bf2f(b.y & 0xffffu), bf2f(b.y >> 16)}; }
                else { const size_t co = (((size_t)(l * NBS + n) * WINB + idx) * 8 + h) * 64 + 4 * sub; kv = *(const f32x4*)(p.in[I_CK] + co); vv = *(const f32x4*)(p.in[I_CV] + co); }
                float d = (q.x * kv.x + q.y * kv.y) + (q.z * kv.z + q.w * kv.w);
                d += __shfl_xor(d, 1); d += __shfl_xor(d, 2); d += __shfl_xor(d, 4); d += __shfl_xor(d, 8);
                if (ok) { const float sc = d * 0.125f + p.in[I_RELB][rel_bucket(m * dil) * 8 + h]; const float mn = fmaxf(mr, sc), cr = __expf(mr - mn), pe = __expf(sc - mn);
                    lr = lr * cr + pe; o = o * cr + vv * pe; mr = mn; }
            } }
#pragma unroll
        for (int x = 16; x < 64; x <<= 1) { const float m2 = __shfl_xor(mr, x), l2 = __shfl_xor(lr, x); f32x4 o2; o2.x = __shfl_xor(o.x, x); o2.y = __shfl_xor(o.y, x); o2.z = __shfl_xor(o.z, x); o2.w = __shfl_xor(o.w, x);
            const float mn = fmaxf(mr, m2), c1 = __expf(mr - mn), c2 = __expf(m2 - mn); lr = lr * c1 + l2 * c2; o = o * c1 + o2 * c2; mr = mn; }
        if (ks == 0) { const float inv = 1.0f / lr; u32x2 w; w.x = pk2(o.x * inv, o.y * inv); w.y = pk2(o.z * inv, o.w * inv); *(u32x2*)(wsb(p, WS_MIX) + (size_t)row * DM + 512 + h * 64 + 4 * sub) = w; }
    }
}

__device__ __forceinline__ void split_bf16x8(const f32x4 a0, const f32x4 a1, bf16x8& hi, bf16x8& lo) {
    u32x4 h, l_;
    h.x = pk2(a0.x, a0.y); h.y = pk2(a0.z, a0.w); h.z = pk2(a1.x, a1.y); h.w = pk2(a1.z, a1.w);
    l_.x = pk2(a0.x - bf2f(h.x & 0xffffu), a0.y - bf2f(h.x >> 16)); l_.y = pk2(a0.z - bf2f(h.y & 0xffffu), a0.w - bf2f(h.y >> 16));
    l_.z = pk2(a1.x - bf2f(h.z & 0xffffu), a1.y - bf2f(h.z >> 16)); l_.w = pk2(a1.z - bf2f(h.w & 0xffffu), a1.w - bf2f(h.w >> 16));
    hi = __builtin_bit_cast(bf16x8, h); lo = __builtin_bit_cast(bf16x8, l_);
}
__device__ __forceinline__ void ph_lora_t(const P& p) {
    bf16* w2t = wsb(p, WS_LORA); bf16* a2t = w2t + NL * 256 * 64; bf16* g2t = a2t + NL * 256 * 64;
    const int gt = BIDX * NTHR + TIDX, NT = GDIM * NTHR;
    for (int i = gt; i < NL * 256 * 64; i += NT) { const int k = i & 63, c = (i >> 6) & 255, l = i >> 14;
        w2t[i] = (bf16)f2bf(p.in[I_W2][((size_t)l * 64 + k) * 256 + c]); a2t[i] = (bf16)f2bf(p.in[I_A2][((size_t)l * 64 + k) * 256 + c]); }
    for (int i = gt; i < NL * 256 * 128; i += NT) { const int k = i & 127, c = (i >> 7) & 255, l = i >> 15; g2t[i] = (bf16)f2bf(p.in[I_G2][((size_t)l * 128 + k) * 256 + c]); }
}
__device__ __forceinline__ f32x4 bf4(const u32x2 a) { return (f32x4){bf2f(a.x & 0xffffu), bf2f(a.x >> 16), bf2f(a.y & 0xffffu), bf2f(a.y >> 16)}; }
constexpr int CV_Z = 0, CV_Y = 94 * 256 * 2  , CV_END = CV_Y + 64 * 256 * 4;
__device__ __forceinline__ void ph_conv_tile(const P& p, int l, LAS unsigned char* lds) {
    const int tid = TIDX, lane = tid & 63, wave = __builtin_amdgcn_readfirstlane(tid >> 6);
    LAS unsigned short* zt = (LAS unsigned short*)(lds + CV_Z); LAS float* yt = (LAS float*)(lds + CV_Y);
    const bf16* U = wsb(p, WS_U);
    for (int unit = BIDX; unit < MP / 64 + NBS; unit += GDIM) {
        const bool smp = unit >= MP / 64; const int n = smp ? unit - MP / 64 : unit >> 6, t0 = smp ? 0 : (unit & 63) * 64, ntok = smp ? TS : 64;
        const int rowb = smp ? MP + n * TS : n * TP;
        for (int e = tid; e < (ntok + 30) * 64; e += NTHR) { const int rr = e >> 6, c4 = (e & 63) * 4, tau = t0 - 30 + rr; f32x4 z = {0.f, 0.f, 0.f, 0.f};
            if (tau >= 0) { const size_t ro = (size_t)(rowb + tau) * INC; const f32x4 a = bf4(*(const u32x2*)(U + ro + UC_CA + c4)), g = bf4(*(const u32x2*)(U + ro + UC_CG + c4));
                z.x = a.x * sigmoid_f(g.x); z.y = a.y * sigmoid_f(g.y); z.z = a.z * sigmoid_f(g.z); z.w = a.w * sigmoid_f(g.w);
                if (!smp && tau >= TP - 30 && rr >= 30) *(f32x4*)(p.out + O_CONVP + ((size_t)(l * NBP + n) * 30 + (tau - (TP - 30))) * 256 + c4) = z;
                if (smp) *(f32x4*)(p.out + O_CONVS + ((size_t)(l * NBS + n) * 30 + 26 + tau) * 256 + c4) = z; }
            else if (smp) { z = *(const f32x4*)(p.in[I_CCONV] + ((size_t)(l * NBS + n) * 30 + 30 + tau) * 256 + c4);
                if (30 + tau >= 4) *(f32x4*)(p.out + O_CONVS + ((size_t)(l * NBS + n) * 30 + 26 + tau) * 256 + c4) = z; }
            u32x2 w; w.x = pk2(z.x, z.y); w.y = pk2(z.z, z.w); *(LAS u32x2*)(zt + rr * 256 + c4) = w; }
        __syncthreads();
        { const int c = tid & 255; float wt[CKW];
#pragma unroll
            for (int j = 0; j < CKW; ++j) wt[j] = p.in[I_CONVW][((size_t)l * CKW + j) * 256 + c];
            const float cb = p.in[I_CONVB][l * 256 + c];
            for (int tg = tid >> 8; tg * 8 < ntok; tg += 2) { float zz[38];
#pragma unroll
                for (int j = 0; j < 38; ++j) zz[j] = (tg * 8 + j < ntok + 30) ? bf2f(zt[(tg * 8 + j) * 256 + c]) : 0.f;
#pragma unroll
                for (int o = 0; o < 8; ++o) { float acc = cb;
#pragma unroll
                    for (int j = 0; j < CKW; ++j) acc += wt[j] * zz[o + j];
                    if (tg * 8 + o < ntok) yt[(tg * 8 + o) * 256 + c] = acc; } } }
        __syncthreads();
        for (int t = wave; t < ntok; t += NWAVES) { const f32x4 y = *(const LAS f32x4*)(yt + t * 256 + 4 * lane);
            const float mean = wave_sum((y.x + y.y) + (y.z + y.w)) * (1.f / 256.f); const f32x4 d = y - mean;
            const float rstd = 1.0f / sqrtf(wave_sum((d.x * d.x + d.y * d.y) + (d.z * d.z + d.w * d.w)) * (1.f / 256.f) + 1e-5f);
            const f32x4 g = *(const f32x4*)(p.in[I_CLNG] + l * 256 + 4 * lane), b = *(const f32x4*)(p.in[I_CLNB] + l * 256 + 4 * lane);
            f32x4 o = d * rstd * g + b; o.x *= sigmoid_f(o.x); o.y *= sigmoid_f(o.y); o.z *= sigmoid_f(o.z); o.w *= sigmoid_f(o.w);
            u32x2 w; w.x = pk2(o.x, o.y); w.y = pk2(o.z, o.w); *(u32x2*)(wsb(p, WS_MIX) + (size_t)(rowb + t0 + t) * DM + 4 * lane) = w; }
        __syncthreads();
    }
}
typedef float f32x16 __attribute__((ext_vector_type(16)));
constexpr int RCH = 32, NCHK = TP / RCH, NUNIT = NBP * 4 * NCHK, RW2_LDS = 14592;
__device__ __forceinline__ float lerp1(float u, float pv, float mu) { return u + (pv - u) * mu; }
__device__ __forceinline__ float tanh_fast(float x) { return 1.0f - 2.0f / (1.0f + __expf(2.0f * x)); }
template <int ACT> __device__ __forceinline__ bf16x8 xs_frag(const bf16* cur, const bf16* prv, const float pm, const float* mu) {
    const u32x4 c = *(const u32x4*)cur, q = *(const u32x4*)prv;
    const f32x4 m0 = *(const f32x4*)mu, m1 = *(const f32x4*)(mu + 4);
    float x[8]; const unsigned cw[4] = {c.x, c.y, c.z, c.w}, qw[4] = {q.x, q.y, q.z, q.w}; const float mm[8] = {m0.x, m0.y, m0.z, m0.w, m1.x, m1.y, m1.z, m1.w};
#pragma unroll
    for (int i = 0; i < 4; ++i) { x[2 * i] = lerp1(bf2f(cw[i] & 0xffffu), pm * bf2f(qw[i] & 0xffffu), mm[2 * i]); x[2 * i + 1] = lerp1(bf2f(cw[i] >> 16), pm * bf2f(qw[i] >> 16), mm[2 * i + 1]); }
#pragma unroll
    for (int i = 0; i < 8; ++i) { if (ACT == 1) x[i] = tanh_fast(x[i]); if (ACT == 2) x[i] = sigmoid_f(x[i]); }
    u32x4 t; t.x = pk2(x[0], x[1]); t.y = pk2(x[2], x[3]); t.z = pk2(x[4], x[5]); t.w = pk2(x[6], x[7]); return __builtin_bit_cast(bf16x8, t);
}
__device__ __forceinline__ void pt_frag_store(LAS unsigned short* ptl, u32x4* fp, int lane) {
    asm volatile("s_waitcnt lgkmcnt(0)" ::: "memory");
#pragma unroll
    for (int kt = 0; kt < 4; ++kt)
#pragma unroll
        for (int ks = 0; ks < 2; ++ks) { const LAS unsigned short* rp = ptl + (16 * kt + (lane & 15)) * 64 + 32 * ks + 4 * (lane >> 4); const u32x2 lo = *(const LAS u32x2*)rp, hi = *(const LAS u32x2*)(rp + 16);
            fp[(kt * 2 + ks) * 64 + lane] = (u32x4){lo.x, lo.y, hi.x, hi.y}; }
    asm volatile("s_waitcnt lgkmcnt(0)" ::: "memory");
}
__device__ __forceinline__ void ph_rwkv_chunk2(const P& p, int l, LAS unsigned char* lds) {
    const int tid = TIDX, lane_u = tid & 63, wave = __builtin_amdgcn_readfirstlane(tid >> 6);
    LAS float* wl = (LAS float*)(lds + wave * RW2_LDS); LAS float* vb = wl + 4 * 8 * 64; LAS float* tw = vb + 8 * 64; LAS float* ta = tw + 8 * 64; LAS float* gb = ta + 8 * 64;
    const bf16* U = wsb(p, WS_U); float* YL = wsf(p, WS_YR); bf16* QIb = wsb(p, WS_QI);
    const bf16* w2t = wsb(p, WS_LORA) + (size_t)l * 256 * 64; const bf16* a2t = wsb(p, WS_LORA) + (size_t)(NL + l) * 256 * 64;
    const float* mu = p.in[I_MU] + l * 1024;
    const int gw = BIDX * NWAVES + wave, NGW = GDIM * NWAVES;
    for (int u = gw; u < NUNIT; u += NUNIT) {
        const int lane = opaque_v(lane_u), l15 = lane & 15, g = lane >> 4;
        const int n = u >> 9, h = (u >> 7) & 3, c = u & 127, row0 = n * TP + c * RCH, hc = h * 64, cc = l * 256 + hc + lane;
        const float mur = mu[hc + lane], muk = mu[256 + hc + lane], muv = mu[512 + hc + lane];
        const float kkw = p.in[I_KK][cc], kaw = p.in[I_KA][cc], rkw = p.in[I_RK][cc];
        float* WL = wsf(p, WS_STR) + S_W * STR_STRIDE; float* AL = wsf(p, WS_STR) + S_KK * STR_STRIDE;
#pragma unroll 1
        for (int mt = 0; mt < 2; ++mt) { const int row = row0 + 16 * mt + l15; const bool nop = (c == 0 && mt == 0 && l15 == 0); const bf16* cu = U + (size_t)row * INC + UC_R + 8 * g; const bf16* pr = nop ? cu : cu - INC; const float pm = nop ? 0.f : 1.f;
            const bf16x8 aw0 = xs_frag<1>(cu + 768, pr + 768, pm, mu + 768 + 8 * g), aw1 = xs_frag<1>(cu + 800, pr + 800, pm, mu + 800 + 8 * g);
            const bf16x8 aa0 = xs_frag<0>(cu + 832, pr + 832, pm, mu + 832 + 8 * g), aa1 = xs_frag<0>(cu + 864, pr + 864, pm, mu + 864 + 8 * g);
#pragma unroll
            for (int ct = 0; ct < 4; ++ct) { const int col = hc + 16 * ct + l15; const bf16* bw = w2t + (size_t)col * 64 + 8 * g; const bf16* ba = a2t + (size_t)col * 64 + 8 * g;
                f32x4 dw = {0.f, 0.f, 0.f, 0.f}, da = {0.f, 0.f, 0.f, 0.f};
                dw = __builtin_amdgcn_mfma_f32_16x16x32_bf16(aw0, *(const bf16x8*)bw, dw, 0, 0, 0); dw = __builtin_amdgcn_mfma_f32_16x16x32_bf16(aw1, *(const bf16x8*)(bw + 32), dw, 0, 0, 0);
                da = __builtin_amdgcn_mfma_f32_16x16x32_bf16(aa0, *(const bf16x8*)ba, da, 0, 0, 0); da = __builtin_amdgcn_mfma_f32_16x16x32_bf16(aa1, *(const bf16x8*)(ba + 32), da, 0, 0, 0);
                const float w0c = p.in[I_W0][l * 256 + col], a0c = p.in[I_A0][l * 256 + col];
#pragma unroll
                for (int r = 0; r < 4; ++r) { const size_t o = (size_t)(row0 + 16 * mt + 4 * g + r) * 256 + col;
                    WL[o] = __expf(-0.6065306597126334f * sigmoid_f(w0c + dw[r])); AL[o] = sigmoid_f(a0c + da[r]); } } }
        asm volatile("s_waitcnt vmcnt(0)" ::: "memory");
        float SI[64], SR[64]; { const int ln = opaque_v(lane);
#pragma unroll
        for (int k = 0; k < 64; ++k) { SI[k] = (k == ln) ? 1.f : 0.f; SR[k] = 0.f; } }
        float gam = 1.f;
        for (int sb = 0; sb < RCH / 8; ++sb) { const int t0 = row0 + sb * 8; const bool first = (c == 0 && sb == 0); const int lane = opaque_v(lane_u);
#pragma unroll 1
            for (int hf = 0; hf < 2; ++hf) { const int tb = t0 + 4 * hf;
                float ur[5], uk[5], uv[5], wv_[4], av_[4];
#pragma unroll
                for (int i = 0; i < 4; ++i) { const size_t o = (size_t)(tb + i) * 256 + hc + lane; wv_[i] = WL[o]; av_[i] = AL[o]; }
#pragma unroll
                for (int i = 0; i < 5; ++i) { const bool z = first && hf == 0 && i == 0; const bf16* rp = U + (size_t)(tb - 1 + i + (z ? 1 : 0)) * INC + UC_R + hc + lane; const float zm = z ? 0.f : 1.f;
                    ur[i] = zm * bf2f(rp[0]); uk[i] = zm * bf2f(rp[256]); uv[i] = zm * bf2f(rp[512]); }
#pragma unroll
                for (int i = 0; i < 4; ++i) { const int ii = 4 * hf + i;
                    const float r = lerp1(ur[i + 1], ur[i], mur), k = lerp1(uk[i + 1], uk[i], muk), v = lerp1(uv[i + 1], uv[i], muv);
                    const float a = av_[i], w = wv_[i];
                    float kk = k * kkw; kk = kk / fmaxf(sqrtf(wave_sum(kk * kk)), 1e-12f);
                    const float kp = k * (1.0f + (a - 1.0f) * kaw); const float bon = wave_sum(r * kp * rkw);
                    if (lane == 0) wsf(p, WS_BON)[(size_t)(tb + i) * 4 + h] = bon;
                    const float gp = gam; gam *= w; const float inv = 1.0f / gam;
                    wl[(0 * 8 + ii) * 64 + lane] = gp * kk; wl[(1 * 8 + ii) * 64 + lane] = kk * a * inv; wl[(2 * 8 + ii) * 64 + lane] = kp * inv; wl[(3 * 8 + ii) * 64 + lane] = gam * r; vb[ii * 64 + lane] = v; } }
            asm volatile("s_waitcnt lgkmcnt(0)" ::: "memory");
#pragma unroll 1
            for (int i = 0; i < 8; ++i) {
                float uI0 = 0.f, uI1 = 0.f, uR0 = 0.f, uR1 = 0.f;
#pragma unroll
                for (int k = 0; k < 64; k += 4) { const f32x4 a = *(const LAS f32x4*)&wl[(0 * 8 + i) * 64 + k];
                    uI0 += SI[k] * a.x; uI1 += SI[k + 1] * a.y; uI0 += SI[k + 2] * a.z; uI1 += SI[k + 3] * a.w;
                    uR0 += SR[k] * a.x; uR1 += SR[k + 1] * a.y; uR0 += SR[k + 2] * a.z; uR1 += SR[k + 3] * a.w; }
                const float uI = uI0 + uI1, uR = uR0 + uR1, vv = vb[i * 64 + lane];
                float yI0 = 0.f, yI1 = 0.f, yR0 = 0.f, yR1 = 0.f;
#pragma unroll
                for (int k = 0; k < 64; k += 4) { const f32x4 b = *(const LAS f32x4*)&wl[(1 * 8 + i) * 64 + k], kp = *(const LAS f32x4*)&wl[(2 * 8 + i) * 64 + k], rh = *(const LAS f32x4*)&wl[(3 * 8 + i) * 64 + k];
                    SI[k] -= uI * b.x; SI[k + 1] -= uI * b.y; SI[k + 2] -= uI * b.z; SI[k + 3] -= uI * b.w;
                    SR[k] += vv * kp.x - uR * b.x; SR[k + 1] += vv * kp.y - uR * b.y; SR[k + 2] += vv * kp.z - uR * b.z; SR[k + 3] += vv * kp.w - uR * b.w;
                    yI0 += SI[k] * rh.x; yI1 += SI[k + 1] * rh.y; yI0 += SI[k + 2] * rh.z; yI1 += SI[k + 3] * rh.w;
                    yR0 += SR[k] * rh.x; yR1 += SR[k + 1] * rh.y; yR0 += SR[k + 2] * rh.z; yR1 += SR[k + 3] * rh.w; }
                const size_t o = (size_t)(t0 + i) * 256 + hc + lane;
                QIb[o] = (bf16)f2bf(yI0 + yI1); YL[o] = yR0 + yR1;
            }
            asm volatile("s_waitcnt lgkmcnt(0)" ::: "memory");
        }
        gb[lane] = gam;
        asm volatile("s_waitcnt lgkmcnt(0)" ::: "memory");
#pragma unroll
        for (int k = 0; k < 64; k += 4) { const f32x4 gg = *(const LAS f32x4*)&gb[k]; SI[k] *= gg.x; SI[k + 1] *= gg.y; SI[k + 2] *= gg.z; SI[k + 3] *= gg.w; SR[k] *= gg.x; SR[k + 1] *= gg.y; SR[k + 2] *= gg.z; SR[k + 3] *= gg.w;
            asm volatile("" : "+v"(SI[k]), "+v"(SI[k + 1]), "+v"(SI[k + 2]), "+v"(SI[k + 3]), "+v"(SR[k]), "+v"(SR[k + 1]), "+v"(SR[k + 2]), "+v"(SR[k + 3])); }
        const int lane_o = opaque_v(lane);
        { f32x4* fl = (f32x4*)(p.ws + WS_LT) + (size_t)u * 1024; const int lane = lane_o;
#pragma unroll
          for (int m = 0; m < 16; ++m) fl[((lane >> 4) * 4 + (m >> 2)) * 64 + (lane & 15) + 16 * (m & 3)] = (f32x4){SR[4 * m], SR[4 * m + 1], SR[4 * m + 2], SR[4 * m + 3]}; }
        LAS unsigned short* ptl = (LAS unsigned short*)wl;
#pragma unroll
        for (int k = 0; k < 64; ++k) ptl[k * 64 + lane_o] = (unsigned short)f2bf(SI[k]);
        pt_frag_store(ptl, (u32x4*)(p.ws + WS_PT) + ((size_t)u * 2 + 0) * 512, lane_o);
#pragma unroll
        for (int k = 0; k < 64; ++k) { SI[k] -= bf2f(f2bf(SI[k])); asm volatile("" : "+v"(SI[k])); }
#pragma unroll
        for (int k = 0; k < 64; ++k) ptl[k * 64 + lane_o] = (unsigned short)f2bf(SI[k]);
        pt_frag_store(ptl, (u32x4*)(p.ws + WS_PT) + ((size_t)u * 2 + 1) * 512, lane_o);
    }
}
struct CarryFr { bf16x8 ah[4][2], al[4][2]; f32x4 lf[4]; };
__device__ __forceinline__ void carry_load(CarryFr& f, const unsigned char* ws, int u, int vq, int lane) {
    const u32x4* fp = (const u32x4*)(ws + WS_PT) + (size_t)u * 1024; const f32x4* fl = (const f32x4*)(ws + WS_LT) + (size_t)u * 1024 + vq * 256;
#pragma unroll
    for (int kt = 0; kt < 4; ++kt) {
#pragma unroll
        for (int ks = 0; ks < 2; ++ks) { f.ah[kt][ks] = __builtin_bit_cast(bf16x8, fp[(kt * 2 + ks) * 64 + lane]); f.al[kt][ks] = __builtin_bit_cast(bf16x8, fp[512 + (kt * 2 + ks) * 64 + lane]); }
        f.lf[kt] = fl[kt * 64 + lane]; }
}
__device__ __forceinline__ void carry_step(f32x4 (&acc)[4], const CarryFr& f, u32x4* ssf, int lane) {
    bf16x8 bh[2], bl[2];
#pragma unroll
    for (int ks = 0; ks < 2; ++ks) { split_bf16x8(acc[2 * ks], acc[2 * ks + 1], bh[ks], bl[ks]); ssf[ks * 64 + lane] = __builtin_bit_cast(u32x4, bh[ks]); }
#pragma unroll
    for (int kt = 0; kt < 4; ++kt) { f32x4 a = f.lf[kt];
#pragma unroll
        for (int ks = 0; ks < 2; ++ks) { a = __builtin_amdgcn_mfma_f32_16x16x32_bf16(f.ah[kt][ks], bh[ks], a, 0, 0, 0); a = __builtin_amdgcn_mfma_f32_16x16x32_bf16(f.ah[kt][ks], bl[ks], a, 0, 0, 0); a = __builtin_amdgcn_mfma_f32_16x16x32_bf16(f.al[kt][ks], bh[ks], a, 0, 0, 0); }
        acc[kt] = a; }
}
__device__ __forceinline__ void ph_rwkv_carry2(const P& p, int l, int ch, int vq) {
    const int lane = TIDX & 63, v16 = lane & 15, g = lane >> 4;
    f32x4 acc[4];
#pragma unroll
    for (int kt = 0; kt < 4; ++kt) acc[kt] = (f32x4){0.f, 0.f, 0.f, 0.f};
    u32x4* ssf = (u32x4*)(p.ws + WS_SSF) + ((size_t)ch * NCHK * 4 + vq) * 128;
    CarryFr f0, f1; const int u0 = ch * NCHK;
    carry_load(f0, p.ws, u0, vq, lane);
    for (int c = 0; c < NCHK; c += 2) {
        carry_load(f1, p.ws, u0 + c + 1, vq, lane);
        carry_step(acc, f0, ssf + (size_t)c * 512, lane);
        carry_load(f0, p.ws, u0 + (c + 2 < NCHK ? c + 2 : c), vq, lane);
        carry_step(acc, f1, ssf + (size_t)(c + 1) * 512, lane);
    }
    float* so = p.out + O_WKVP + ((size_t)(l * NBP * 4 + ch) * 64 + 16 * vq + v16) * 64;
#pragma unroll
    for (int kt = 0; kt < 4; ++kt) *(f32x4*)(so + 16 * kt + 4 * g) = acc[kt];
}
__device__ __forceinline__ void ph_rwkv_fix2(const P& p, int l) {
    const int tid = TIDX, lane = tid & 63, wave = __builtin_amdgcn_readfirstlane(tid >> 6), t16 = lane & 15, g = lane >> 4;
    const bf16* U = wsb(p, WS_U); const float* YL = wsf(p, WS_YR); const bf16* QIb = wsb(p, WS_QI); const u32x4* SSf = (const u32x4*)(p.ws + WS_SSF);
    const bf16* g2t = wsb(p, WS_LORA) + (size_t)2 * NL * 256 * 64 + (size_t)l * 256 * 128; const float* mu = p.in[I_MU] + l * 1024;
    const int gw = BIDX * NWAVES + wave, NGW = GDIM * NWAVES;
    for (int u = gw; u < NUNIT; u += NGW) {
        const int n = u >> 9, h = (u >> 7) & 3, c = u & 127, row0 = n * TP + c * RCH, hc = h * 64;
#pragma unroll 1
        for (int tt = 0; tt < 2; ++tt) { const int row = row0 + 16 * tt + t16; const bool nop = (c == 0 && tt == 0 && t16 == 0);
            const bf16* cu = U + (size_t)row * INC + UC_R; const bf16* pr = nop ? cu : cu - INC; const float pm = nop ? 0.f : 1.f;
            f32x4 acc[4], ag[4];
#pragma unroll
            for (int vq = 0; vq < 4; ++vq) { acc[vq] = (f32x4){0.f, 0.f, 0.f, 0.f}; ag[vq] = (f32x4){0.f, 0.f, 0.f, 0.f}; }
#pragma unroll
            for (int ks = 0; ks < 2; ++ks) { const bf16* qp = QIb + (size_t)row * 256 + hc + 32 * ks + 4 * g; const u32x2 q0 = *(const u32x2*)qp, q1 = *(const u32x2*)(qp + 16);
                const bf16x8 qf = __builtin_bit_cast(bf16x8, ((u32x4){q0.x, q0.y, q1.x, q1.y}));
#pragma unroll
                for (int vq = 0; vq < 4; ++vq) acc[vq] = __builtin_amdgcn_mfma_f32_16x16x32_bf16(__builtin_bit_cast(bf16x8, SSf[((size_t)(u * 4 + vq) * 2 + ks) * 64 + lane]), qf, acc[vq], 0, 0, 0); }
#pragma unroll
            for (int ks = 0; ks < 4; ++ks) { const bf16x8 sg = xs_frag<2>(cu + 896 + 32 * ks + 8 * g, pr + 896 + 32 * ks + 8 * g, pm, mu + 896 + 32 * ks + 8 * g);
#pragma unroll
                for (int vq = 0; vq < 4; ++vq) ag[vq] = __builtin_amdgcn_mfma_f32_16x16x32_bf16(*(const bf16x8*)(g2t + (size_t)(hc + 16 * vq + t16) * 128 + 32 * ks + 8 * g), sg, ag[vq], 0, 0, 0); }
            float s1 = 0.f;
#pragma unroll
            for (int vq = 0; vq < 4; ++vq) { acc[vq] += *(const f32x4*)(YL + (size_t)row * 256 + hc + 16 * vq + 4 * g); s1 += (acc[vq].x + acc[vq].y) + (acc[vq].z + acc[vq].w); }
            s1 += __shfl_xor(s1, 16); s1 += __shfl_xor(s1, 32); const float mean = s1 * (1.f / 64.f); float s2 = 0.f;
#pragma unroll
            for (int vq = 0; vq < 4; ++vq) { acc[vq] = acc[vq] - mean; s2 += (acc[vq].x * acc[vq].x + acc[vq].y * acc[vq].y) + (acc[vq].z * acc[vq].z + acc[vq].w * acc[vq].w); }
            s2 += __shfl_xor(s2, 16); s2 += __shfl_xor(s2, 32); const float rstd = 1.0f / sqrtf(s2 * (1.f / 64.f) + 64e-5f);
            const float bon = wsf(p, WS_BON)[(size_t)row * 4 + h];
#pragma unroll
            for (int vq = 0; vq < 4; ++vq) { const int vv = hc + 16 * vq + 4 * g;
                const f32x4 lg = *(const f32x4*)(p.in[I_LNG] + l * 256 + vv), lb = *(const f32x4*)(p.in[I_LNB] + l * 256 + vv), mv = *(const f32x4*)(mu + 512 + vv);
                const f32x4 vc = bf4(*(const u32x2*)(cu + 512 + vv)); const f32x4 vp = bf4(*(const u32x2*)(pr + 512 + vv)) * pm;
                const f32x4 V = vc + (vp - vc) * mv; const f32x4 o = (acc[vq] * rstd * lg + lb + V * bon) * ag[vq];
                u32x2 w; w.x = pk2(o.x, o.y); w.y = pk2(o.z, o.w); *(u32x2*)(wsb(p, WS_MIX) + (size_t)row * DM + 256 + vv) = w; }
        }
    }
}
#ifndef PROBE
#define PROBE 0
#endif
constexpr int LDSCTL_OFF = 131072, LDS_BYTES = 147456, CW_BAR = 1024;
constexpr size_t CTL_ZERO_BYTES = 65536;
constexpr int CARRY_BLOCKS = 16;
#define GRID_BAR() do { XcdBarrier b_; b_.bar = (unsigned*)(p_.ws + WS_CTL) + CW_BAR; b_.x = xb_xcc_id(); b_.st = (volatile LAS unsigned*)(lds + LDSCTL_OFF + 32); xcd_barrier(b_); } while (0)
__global__ void __launch_bounds__(NTHR, 2) fwd(P p_) {
    extern __shared__ __attribute__((aligned(16))) unsigned char lds_raw[];
    LAS unsigned char* lds = (LAS unsigned char*)lds_raw;
    if (threadIdx.x < 64) ((LAS unsigned*)(lds + LDSCTL_OFF))[threadIdx.x] = 0u;
    __syncthreads();
    (void)xcd_barrier_post((unsigned*)(p_.ws + WS_CTL) + CW_BAR, (volatile LAS unsigned*)(lds + LDSCTL_OFF + 32));
    const int G = gridDim.x, bx = blockIdx.x;
    ph_transpose(p_, lds); ph_silu(p_); ph_lora_t(p_);
    GRID_BAR();
    ph_mod(p_, lds);
    GRID_BAR();
    ph_norm0(p_);
    GRID_BAR();
    for (int l_ = 0; l_ < NL; ++l_) {
        ph_gemm<0>(p_, opaque_s(l_), lds);
        GRID_BAR();
        ph_rwkv_chunk2(p_, opaque_s(l_), lds);
        __syncthreads();
        ph_conv_tile(p_, opaque_s(l_), lds);
        ph_copy_out(p_, opaque_s(l_));
        ph_rwkv_prep(p_, opaque_s(l_), lds);
        GRID_BAR();
        if (bx < CARRY_BLOCKS) { const int wv = __builtin_amdgcn_readfirstlane(opaque_v((int)threadIdx.x) >> 6); if (wv < 4) ph_rwkv_carry2(p_, opaque_s(l_), opaque_s(bx), wv); }
        else { { const int wv = __builtin_amdgcn_readfirstlane(opaque_v((int)threadIdx.x) >> 6); const int u = (opaque_s(bx) - CARRY_BLOCKS) * NWAVES + wv; if (u < NBS * 4) { ph_rwkv_scan(p_, opaque_s(l_), lds + wv * RW2_LDS, NBP * 4 + u); } }
            __syncthreads();
            ph_attn_p(p_, lds, opaque_s(bx - CARRY_BLOCKS), opaque_s(G - CARRY_BLOCKS)); ph_attn_s(p_, opaque_s(l_), opaque_s(bx - CARRY_BLOCKS), opaque_s(G - CARRY_BLOCKS)); }
        GRID_BAR();
        ph_rwkv_fix2(p_, opaque_s(l_)); ph_rwkv_post(p_, opaque_s(l_)); ph_attn_merge(p_, opaque_s(bx), opaque_s(G));
        GRID_BAR();
#if PROBE == 1
        if (bx < CARRY_BLOCKS) { const int wv = __builtin_amdgcn_readfirstlane(opaque_v((int)threadIdx.x) >> 6); if (wv < 4) ph_rwkv_carry2(p_, opaque_s(l_), opaque_s(bx), wv); } GRID_BAR();
#elif PROBE == 4
        ph_rwkv_chunk2(p_, opaque_s(l_), lds); GRID_BAR();
#elif PROBE == 5
        ph_rwkv_fix2(p_, opaque_s(l_)); GRID_BAR();
#elif PROBE == 6
        ph_conv_tile(p_, opaque_s(l_), lds); GRID_BAR();
#endif
        ph_gemm<1>(p_, opaque_s(l_), lds);
        GRID_BAR();
        ph_resid(p_, opaque_s(l_), 0);
        GRID_BAR();
        ph_gemm<2>(p_, opaque_s(l_), lds);
        GRID_BAR();
        ph_gemm<3>(p_, opaque_s(l_), lds);
        GRID_BAR();
        ph_resid(p_, opaque_s(l_), 1);
        if (l_ + 1 < NL) GRID_BAR();
    }
}

extern "C" void kernel_launch(void* const* d_in, const int* in_sizes, int n_in, void* d_out, int out_size, void* d_ws, size_t ws_size, hipStream_t stream) {
    static int grid = 0;
    if (grid == 0) {
        if (n_in != N_IN || (size_t)out_size != O_END || ws_size < WS_END) { fprintf(stderr, "kernel_launch: unexpected sizes n_in %d out %d ws %zu (want %d %zu %zu)\n", n_in, out_size, ws_size, (int)N_IN, (size_t)O_END, (size_t)WS_END); grid = -1; return; }
        int dev = 0, cus = 0, per_cu = 0;
        if (hipGetDevice(&dev) != hipSuccess || hipDeviceGetAttribute(&cus, hipDeviceAttributeMultiprocessorCount, dev) != hipSuccess) { grid = -1; return; }
        if (hipFuncSetAttribute((const void*)fwd, hipFuncAttributeMaxDynamicSharedMemorySize, LDS_BYTES) != hipSuccess) { fprintf(stderr, "kernel_launch: hipFuncSetAttribute failed\n"); grid = -1; return; }
        if (hipOccupancyMaxActiveBlocksPerMultiprocessor(&per_cu, (const void*)fwd, NTHR, LDS_BYTES) != hipSuccess || per_cu < 1) fprintf(stderr, "kernel_launch: occupancy query says %d\n", per_cu);
        (void)hipGetLastError();
        grid = cus;
        if (grid != 256) fprintf(stderr, "kernel_launch: %d CUs (expected 256)\n", grid);
    }
    if (grid < 0) return;
    (void)hipMemsetAsync((char*)d_ws + WS_CTL, 0, CTL_ZERO_BYTES, stream);
    P p{}; for (int i = 0; i < N_IN; ++i) p.in[i] = (const float*)d_in[i]; p.out = (float*)d_out; p.ws = (unsigned char*)d_ws;
    hipLaunchKernelGGL(fwd, dim3(grid), dim3(NTHR), LDS_BYTES, stream, p);
}
```
